# Optimizing an MI355X kernel written in HIP

```python
import jax, jax.numpy as jnp
from jax import lax
import numpy as np

D_MODEL = 2048
BATCH = 4
SEQ = 2048
DEPTH = 4
DEC_BATCH = 128
DEC_SEQ = 4
PAST_LEN = 16384
PAGE_SIZE = 128

S5_WIDTH = D_MODEL // 2
S5_GROUP = 16
S5_GROUPS = S5_WIDTH // S5_GROUP
S5_STATE = 64
RG_WIDTH = D_MODEL
RG_BLOCKS = 16
RG_BLOCK = RG_WIDTH // RG_BLOCKS
RG_C = 8.0
CONV_W = 4
IN_COLS = 2 * S5_WIDTH + 2 * RG_WIDTH + 2 * D_MODEL
EPS = 1e-6
DT_MIN = 1e-3
DT_MAX = 1e-1

kernel_name = "hybrid_s5_rglru_gated_step"

_SPLITS = [S5_WIDTH, 2 * S5_WIDTH, 2 * S5_WIDTH + RG_WIDTH, 2 * S5_WIDTH + 2 * RG_WIDTH,
           2 * S5_WIDTH + 2 * RG_WIDTH + D_MODEL]


def _rmsnorm(x, g):
    xf = x.astype(jnp.float32)
    y = xf * lax.rsqrt(jnp.mean(xf * xf, axis=-1, keepdims=True) + EPS)
    return (y * g.astype(jnp.float32)).astype(x.dtype)


def _complex_linear_scan(a_re, a_im, b_re, b_im):
    def combine(l, r):
        a1r, a1i, b1r, b1i = l
        a2r, a2i, b2r, b2i = r
        return (a1r * a2r - a1i * a2i,
                a1r * a2i + a1i * a2r,
                a2r * b1r - a2i * b1i + b2r,
                a2r * b1i + a2i * b1r + b2i)
    return lax.associative_scan(combine, (a_re, a_im, b_re, b_im), axis=1)


def _real_linear_scan(a, b):
    def combine(l, r):
        a1, b1 = l
        a2, b2 = r
        return a1 * a2, a2 * b1 + b2
    return lax.associative_scan(combine, (a, b), axis=1)


def _s5_branch(u, h0_re, h0_im, p):
    f32 = jnp.float32
    bsz, t = u.shape[0], u.shape[1]
    uf = u.astype(f32).reshape(bsz, t, S5_GROUPS, S5_GROUP)
    lam_re = p["s5_lam_re"].astype(f32)
    lam_im = p["s5_lam_im"].astype(f32)
    dt = jnp.exp(p["s5_log_dt"].astype(f32))[:, None]
    mag = jnp.exp(lam_re * dt)
    abar_re = mag * jnp.cos(lam_im * dt)
    abar_im = mag * jnp.sin(lam_im * dt)
    nr = abar_re - 1.0
    ni = abar_im
    den = lam_re * lam_re + lam_im * lam_im
    coef_re = ((nr * lam_re + ni * lam_im) / den)[..., None]
    coef_im = ((ni * lam_re - nr * lam_im) / den)[..., None]
    b_re = p["s5_b_re"].astype(f32)
    b_im = p["s5_b_im"].astype(f32)
    bb_re = coef_re * b_re - coef_im * b_im
    bb_im = coef_re * b_im + coef_im * b_re
    bu_re = jnp.einsum("gpc,btgc->btgp", bb_re, uf)
    bu_im = jnp.einsum("gpc,btgc->btgp", bb_im, uf)
    h0r = h0_re.astype(f32)
    h0i = h0_im.astype(f32)
    bu_re = bu_re.at[:, 0].add(abar_re * h0r - abar_im * h0i)
    bu_im = bu_im.at[:, 0].add(abar_re * h0i + abar_im * h0r)
    a_re = jnp.broadcast_to(abar_re, bu_re.shape)
    a_im = jnp.broadcast_to(abar_im, bu_im.shape)
    _, _, h_re, h_im = _complex_linear_scan(a_re, a_im, bu_re, bu_im)
    y = (jnp.einsum("gcp,btgp->btgc", p["s5_c_re"].astype(f32), h_re)
         - jnp.einsum("gcp,btgp->btgc", p["s5_c_im"].astype(f32), h_im))
    y = y.reshape(bsz, t, S5_WIDTH) + p["s5_d"].astype(f32) * u.astype(f32)
    y = jax.nn.gelu(y, approximate=False)
    y = y * jax.nn.sigmoid(y @ p["s5_w_glu"].astype(f32) + p["s5_b_glu"].astype(f32))
    return y.astype(u.dtype), h_re[:, -1], h_im[:, -1]


def _rglru_branch(xb, h0, conv_buf, p):
    f32 = jnp.float32
    bsz, t = xb.shape[0], xb.shape[1]
    xcat = jnp.concatenate([conv_buf.astype(xb.dtype), xb], axis=1)
    new_buf = xcat[:, -(CONV_W - 1):]
    w = p["rg_conv_w"]
    conv = p["rg_conv_b"] + sum(w[k] * xcat[:, k:k + t] for k in range(CONV_W))
    xh = conv.reshape(bsz, t, RG_BLOCKS, RG_BLOCK)
    r = jax.nn.sigmoid(jnp.einsum("bthi,hij->bthj", xh, p["rg_w_r"]).reshape(bsz, t, RG_WIDTH)
                       + p["rg_b_r"]).astype(f32)
    gi = jax.nn.sigmoid(jnp.einsum("bthi,hij->bthj", xh, p["rg_w_i"]).reshape(bsz, t, RG_WIDTH)
                        + p["rg_b_i"]).astype(f32)
    log_a = -RG_C * r * jax.nn.softplus(-p["rg_lam"].astype(f32))
    a = jnp.exp(log_a)
    mult = jnp.sqrt(-jnp.expm1(2.0 * log_a))
    b = mult * gi * conv.astype(f32)
    b = b.at[:, 0].add(a[:, 0] * h0.astype(f32))
    _, h = _real_linear_scan(a, b)
    return h.astype(xb.dtype), h[:, -1], new_buf


def _layer(x, c, s5_re0, s5_im0, rg_h0, conv0, p):
    ada = c @ p["w_ada"] + p["b_ada"]
    shift, scale, gate = jnp.split(ada, 3, axis=-1)
    xn = _rmsnorm(x, p["norm_gain"]) * (1.0 + scale[:, None]) + shift[:, None]
    proj = xn @ p["w_in"] + p["b_in"]
    u_a, z_a, x_b, z_b, g_a, g_b = jnp.split(proj, _SPLITS, axis=-1)
    y_a, s5_re, s5_im = _s5_branch(u_a, s5_re0, s5_im0, p)
    y_b, rg_h, conv_buf = _rglru_branch(x_b, rg_h0, conv0, p)
    y_a = y_a * jax.nn.silu(z_a)
    y_b = y_b * jax.nn.silu(z_b)
    merged = (jax.nn.sigmoid(g_a) * (y_a @ p["w_proj_a"])
              + jax.nn.sigmoid(g_b) * (y_b @ p["w_proj_b"]))
    out = merged @ p["w_out"]
    x = x + gate[:, None] * out
    return x, (s5_re, s5_im, rg_h, conv_buf)


def _trunk(x, c, s5_re0, s5_im0, rg_h0, conv0, params, final_gain, state_dtype):
    s5r, s5i, rgh, cnv = [], [], [], []
    for l in range(DEPTH):
        p = {k: v[l] for k, v in params.items()}
        x, (a, b, h, buf) = _layer(x, c, s5_re0[l], s5_im0[l], rg_h0[l], conv0[l], p)
        s5r.append(a.astype(state_dtype))
        s5i.append(b.astype(state_dtype))
        rgh.append(h.astype(state_dtype))
        cnv.append(buf.astype(state_dtype))
    y = _rmsnorm(x, final_gain)
    return y, jnp.stack(s5r), jnp.stack(s5i), jnp.stack(rgh), jnp.stack(cnv)


def setup_inputs(seed: int = 0) -> dict:
    key = jax.random.key(seed)
    ks = iter(jax.random.split(key, 40))
    f32 = jnp.float32

    def nrm(shape, s):
        return jax.random.normal(next(ks), shape, f32) * s

    n_idx = jnp.arange(S5_STATE, dtype=f32)
    u_a = jax.random.uniform(next(ks), (DEPTH, RG_WIDTH), f32, 0.9, 0.999)
    sig = u_a ** (1.0 / RG_C)
    rg_lam = jnp.log(sig) - jnp.log1p(-sig)
    log_dt = jax.random.uniform(next(ks), (DEPTH, S5_GROUPS), f32, np.log(DT_MIN), np.log(DT_MAX))
    return {
        "x_prompt": nrm((BATCH, SEQ, D_MODEL), 1.0),
        "x_sample": nrm((DEC_BATCH, DEC_SEQ, D_MODEL), 1.0),
        "state_s5_re": nrm((DEPTH, DEC_BATCH, S5_GROUPS, S5_STATE), 0.1),
        "state_s5_im": nrm((DEPTH, DEC_BATCH, S5_GROUPS, S5_STATE), 0.1),
        "state_rglru_h": nrm((DEPTH, DEC_BATCH, RG_WIDTH), 0.5),
        "state_conv": nrm((DEPTH, DEC_BATCH, CONV_W - 1, RG_WIDTH), 1.0),
        "c_prompt": nrm((BATCH, D_MODEL), 1.0),
        "c_sample": nrm((DEC_BATCH, D_MODEL), 1.0),
        "w_ada": nrm((DEPTH, D_MODEL, 3 * D_MODEL), 0.5 * D_MODEL ** -0.5),
        "b_ada": nrm((DEPTH, 3 * D_MODEL), 0.01),
        "norm_gain": 1.0 + nrm((DEPTH, D_MODEL), 0.01),
        "w_in": nrm((DEPTH, D_MODEL, IN_COLS), D_MODEL ** -0.5),
        "b_in": nrm((DEPTH, IN_COLS), 0.01),
        "s5_lam_re": -0.5 + nrm((DEPTH, S5_GROUPS, S5_STATE), 0.01),
        "s5_lam_im": jnp.pi * n_idx + nrm((DEPTH, S5_GROUPS, S5_STATE), 0.01),
        "s5_log_dt": log_dt,
        "s5_b_re": nrm((DEPTH, S5_GROUPS, S5_STATE, S5_GROUP), (2 * S5_GROUP) ** -0.5),
        "s5_b_im": nrm((DEPTH, S5_GROUPS, S5_STATE, S5_GROUP), (2 * S5_GROUP) ** -0.5),
        "s5_c_re": nrm((DEPTH, S5_GROUPS, S5_GROUP, S5_STATE), S5_STATE ** -0.5),
        "s5_c_im": nrm((DEPTH, S5_GROUPS, S5_GROUP, S5_STATE), S5_STATE ** -0.5),
        "s5_d": nrm((DEPTH, S5_WIDTH), 1.0),
        "s5_w_glu": nrm((DEPTH, S5_WIDTH, S5_WIDTH), S5_WIDTH ** -0.5),
        "s5_b_glu": nrm((DEPTH, S5_WIDTH), 0.01),
        "rg_conv_w": nrm((DEPTH, CONV_W, RG_WIDTH), CONV_W ** -0.5),
        "rg_conv_b": nrm((DEPTH, RG_WIDTH), 0.01),
        "rg_w_r": nrm((DEPTH, RG_BLOCKS, RG_BLOCK, RG_BLOCK), RG_BLOCK ** -0.5),
        "rg_b_r": nrm((DEPTH, RG_WIDTH), 0.01),
        "rg_w_i": nrm((DEPTH, RG_BLOCKS, RG_BLOCK, RG_BLOCK), RG_BLOCK ** -0.5),
        "rg_b_i": nrm((DEPTH, RG_WIDTH), 0.01),
        "rg_lam": rg_lam,
        "w_proj_a": nrm((DEPTH, S5_WIDTH, D_MODEL), S5_WIDTH ** -0.5),
        "w_proj_b": nrm((DEPTH, RG_WIDTH, D_MODEL), RG_WIDTH ** -0.5),
        "w_out": nrm((DEPTH, D_MODEL, D_MODEL), D_MODEL ** -0.5),
        "final_gain": 1.0 + nrm((D_MODEL,), 0.01),
    }


def reference(x_prompt, x_sample, state_s5_re, state_s5_im, state_rglru_h, state_conv,
              c_prompt, c_sample, w_ada, b_ada, norm_gain, w_in, b_in,
              s5_lam_re, s5_lam_im, s5_log_dt, s5_b_re, s5_b_im, s5_c_re, s5_c_im,
              s5_d, s5_w_glu, s5_b_glu, rg_conv_w, rg_conv_b, rg_w_r, rg_b_r, rg_w_i, rg_b_i,
              rg_lam, w_proj_a, w_proj_b, w_out, final_gain):
    params = {
        "w_ada": w_ada, "b_ada": b_ada, "norm_gain": norm_gain, "w_in": w_in, "b_in": b_in,
        "s5_lam_re": s5_lam_re, "s5_lam_im": s5_lam_im, "s5_log_dt": s5_log_dt,
        "s5_b_re": s5_b_re, "s5_b_im": s5_b_im, "s5_c_re": s5_c_re, "s5_c_im": s5_c_im,
        "s5_d": s5_d, "s5_w_glu": s5_w_glu, "s5_b_glu": s5_b_glu,
        "rg_conv_w": rg_conv_w, "rg_conv_b": rg_conv_b, "rg_w_r": rg_w_r, "rg_b_r": rg_b_r,
        "rg_w_i": rg_w_i, "rg_b_i": rg_b_i, "rg_lam": rg_lam,
        "w_proj_a": w_proj_a, "w_proj_b": w_proj_b, "w_out": w_out,
    }
    sdt = state_s5_re.dtype
    bp = x_prompt.shape[0]
    z_s5 = jnp.zeros((DEPTH, bp, S5_GROUPS, S5_STATE), jnp.float32)
    z_h = jnp.zeros((DEPTH, bp, RG_WIDTH), jnp.float32)
    z_conv = jnp.zeros((DEPTH, bp, CONV_W - 1, RG_WIDTH), x_prompt.dtype)
    y_prompt, s5_re_p, s5_im_p, rg_h_p, conv_p = _trunk(
        x_prompt, c_prompt, z_s5, z_s5, z_h, z_conv, params, final_gain, sdt)
    y_sample, s5_re_s, s5_im_s, rg_h_s, conv_s = _trunk(
        x_sample, c_sample, state_s5_re, state_s5_im, state_rglru_h, state_conv, params, final_gain, sdt)
    return (y_prompt, y_sample, s5_re_p, s5_im_p, rg_h_p, conv_p, s5_re_s, s5_im_s, rg_h_s, conv_s)
```

```cpp
#include <hip/hip_runtime.h>
#include <hip/hip_cooperative_groups.h>
#include <cstdio>
#include <cstdint>
namespace cg = cooperative_groups;

#ifndef MK_MULTI
#define MK_MULTI 0
#endif

#define LAS __attribute__((address_space(3)))
typedef unsigned short bf16_t;
typedef short bf16x8 __attribute__((ext_vector_type(8)));
typedef float f32x4 __attribute__((ext_vector_type(4)));
typedef float f32x2 __attribute__((ext_vector_type(2)));
typedef unsigned u32x4 __attribute__((ext_vector_type(4)));
typedef unsigned u32x2 __attribute__((ext_vector_type(2)));
typedef f32x4 QuarT[4][2];

constexpr int D = 2048, NP = 8192, NSR = 512, MR = 8704, DEPTH = 4, INC = 10240, S5W = 1024;
constexpr int NTILE = 136;
constexpr float EPS = 1e-6f;
enum { I_XP = 0, I_XS, I_S5RE, I_S5IM, I_RGH, I_CONV, I_CP, I_CS, I_WADA, I_BADA, I_NG, I_WIN, I_BIN, I_LAMRE, I_LAMIM, I_LOGDT,
       I_BRE, I_BIM, I_CRE, I_CIM, I_S5D, I_WGLU, I_BGLU, I_CW, I_CBIAS, I_WR, I_BR, I_WI, I_BI, I_LAM, I_WPA, I_WPB, I_WOUT, I_FG, N_IN };
constexpr size_t O_YP = 0, O_YS = O_YP + (size_t)NP * D, O_S5RP = O_YS + (size_t)NSR * D, O_S5IP = O_S5RP + 4 * 4 * 4096,
                 O_RGHP = O_S5IP + 4 * 4 * 4096, O_CONVP = O_RGHP + 4 * 4 * 2048, O_S5RS = O_CONVP + 4 * 4 * 3 * 2048,
                 O_S5IS = O_S5RS + (size_t)4 * 128 * 4096, O_RGHS = O_S5IS + (size_t)4 * 128 * 4096, O_CONVS = O_RGHS + (size_t)4 * 128 * 2048,
                 O_END = O_CONVS + (size_t)4 * 128 * 3 * 2048;
constexpr size_t WS_WT_IN = 0, WS_WT_ADA = WS_WT_IN + (size_t)4 * INC * D * 2, WS_WT_GLU = WS_WT_ADA + (size_t)4 * 6144 * D * 2,
                 WS_WT_PA = WS_WT_GLU + (size_t)4 * 1024 * 1024 * 2, WS_WT_PB = WS_WT_PA + (size_t)4 * 2048 * 1024 * 2,
                 WS_WT_OUT = WS_WT_PB + (size_t)4 * 2048 * 2048 * 2, WS_WT_RG = WS_WT_OUT + (size_t)4 * 2048 * 2048 * 2,
                 WS_CB = WS_WT_RG + (size_t)4 * 2 * 16 * 16384 * 2, WS_ADA = WS_CB + (size_t)256 * D * 2, WS_X = WS_ADA + (size_t)256 * 24576 * 4,
                 WS_XN = WS_X + (size_t)MR * D * 4, WS_PROJ = WS_XN + (size_t)MR * D * 2, WS_YS5 = WS_PROJ + (size_t)MR * INC * 2,
                 WS_YA = WS_YS5 + (size_t)MR * S5W * 2, WS_YB = WS_YA + (size_t)MR * S5W * 2, WS_PB = WS_YB + (size_t)MR * D * 2,
                 WS_MTMP = WS_PB + (size_t)NP * D * 2, WS_MERGED = WS_MTMP + (size_t)MR * D * 4, WS_S5ABAR = WS_MERGED + (size_t)MR * D * 2,
                 WS_S5BBR = WS_S5ABAR + (size_t)4 * 4096 * 16, WS_S5BBI = WS_S5BBR + (size_t)4 * 4096 * 64, WS_S5LOCR = WS_S5BBI + (size_t)4 * 4096 * 64,
                 WS_S5LOCI = WS_S5LOCR + (size_t)4 * 32 * 4096 * 4, WS_RGEND = WS_S5LOCI + (size_t)4 * 32 * 4096 * 4,
                 WS_BAR = WS_RGEND + (size_t)4 * 32 * 2048 * 8, WS_CNT = WS_BAR + 16384, WS_SLAB = WS_CNT + 16384, WS_END = WS_SLAB + (size_t)240 * 262144;
constexpr int LDS_PHASE = 158720, LDS_BYTES = LDS_PHASE + 16;
constexpr int N_PHASES = 2 + 7 * DEPTH + 1;

struct Params { const float* in[N_IN]; float* out; unsigned char* ws; int ph_lo, ph_hi; };

#define KP const __attribute__((address_space(4))) Params
__device__ __forceinline__ int TID() { int t = threadIdx.x; asm volatile("" : "+v"(t)); return t; }
__device__ __forceinline__ int BID() { int t = blockIdx.x; asm volatile("" : "+s"(t)); return t; }
__device__ __forceinline__ int GDIM() { int t = gridDim.x; asm volatile("" : "+s"(t)); return t; }
#define LDS_WAIT() asm volatile("s_waitcnt lgkmcnt(0)" ::: "memory")
__device__ __forceinline__ unsigned pk2(float lo, float hi) { unsigned r; asm("v_cvt_pk_bf16_f32 %0, %1, %2" : "=v"(r) : "v"(lo), "v"(hi)); return r; }
__device__ __forceinline__ float bflo(unsigned w) { return __uint_as_float(w << 16); }
__device__ __forceinline__ float bfhi(unsigned w) { return __uint_as_float(w & 0xffff0000u); }
__device__ __forceinline__ float bf1(bf16_t b) { return __uint_as_float(((unsigned)b) << 16); }
__device__ __forceinline__ float sigm(float x) { return __builtin_amdgcn_rcpf(1.f + __expf(-x)); }
__device__ __forceinline__ float wave_sum(float v) {
#pragma unroll
    for (int o = 1; o < 64; o <<= 1) v += __shfl_xor(v, o);
    return v;
}
__device__ __forceinline__ int row_b(int row) { return row < NP ? (row >> 11) : 4 + ((row - NP) >> 2); }
__device__ __forceinline__ const float* xrow_ptr(KP& p, int l, int row) {
    if (l == 0) return row < NP ? p.in[I_XP] + (size_t)row * D : p.in[I_XS] + (size_t)(row - NP) * D;
    return (const float*)(p.ws + WS_X) + (size_t)row * D;
}

namespace pg8 {
constexpr int BM = 256, BK = 64, HALF = 128, HTB = HALF * BK * 2, STAGE_BYTES = 8 * HTB, NXCD = 8, WGM = 8;
__device__ __forceinline__ int lds_byte(int r, int c) { const int st = (r >> 4) * 2 + (c >> 5), rr = r & 15, cc = c & 31, ob = rr * 64 + cc * 2; return st * 1024 + (ob ^ (((ob >> 9) & 1) << 5)); }
__device__ __forceinline__ void stage_rc(int b, int& R, int& C) { const int st = b / 1024, sb = b % 1024, swz = sb ^ (((sb >> 9) & 1) << 5); R = (st >> 1) * 16 + swz / 64; C = (st & 1) * 32 + (swz % 64) / 2; }
__device__ __forceinline__ int perm32(int rho) { const int n = rho >> 4, i = rho & 15; return 8 * (i >> 2) + 4 * n + (i & 3); }
struct Unit { int pm, pn, kt0, nt; };
struct StaticOrder {
    int nM, nN, nwg, G, c, R, ntail, S, ntK, sl;
    __device__ __forceinline__ void init(int M, int N, int K, int G_, int c_, bool split, int sl_ = 0) { sl = sl_; nM = M / BM; nN = N / BM; nwg = nM * nN; G = G_; c = c_; R = nwg / G; ntail = nwg - R * G; ntK = K / BK;
        S = 1; if (split && ntail > 0) { if (ntail * 4 <= G && ntK >= 16) S = 4; else if (ntail * 3 <= G && ntK == 32) S = 3; else if (ntail * 2 <= G && ntK >= 8) S = 2; } }
    __device__ __forceinline__ void map(int L, Unit& u) const {
        if (sl) { if (L < 256) { u.pm = (L & 7) * 4 + ((L >> 3) & 3); u.pn = L >> 5; } else { u.pm = 32 + ((L - 256) >> 3); u.pn = (L - 256) & 7; } return; }
        int wgid = L; { const int q = nwg / NXCD, r = nwg % NXCD, xcd = wgid % NXCD, off = wgid / NXCD; wgid = (xcd < r ? xcd * (q + 1) : r * (q + 1) + (xcd - r) * q) + off; }
        const int nig = WGM * nN, gid = wgid / nig, fm = gid * WGM, gsz = (nM - fm) < WGM ? (nM - fm) : WGM;
        u.pm = fm + ((wgid % nig) % gsz); u.pn = (wgid % nig) / gsz; }
    __device__ __forceinline__ bool piece(int i, int& tu, int& sl) const { if (i != R || S == 1) return false; const int x = c & 7, y = c >> 3; sl = y % S; tu = (y / S) * 8 + x; return tu < ntail; }
    __device__ __forceinline__ bool next(int i, Unit& u) const {
        u.kt0 = 0; u.nt = ntK;
        if (i < R) { map(i * G + c, u); return true; }
        if (i > R || ntail == 0) return false;
        if (S == 1) { if (c >= ntail) return false; map(R * G + c, u); return true; }
        int tu, s_; if (!piece(i, tu, s_)) return false;
        map(R * G + tu, u);
        if (S == 3) { u.nt = s_ < 2 ? 10 : 12; u.kt0 = s_ * 10; } else { u.nt = ntK / S; u.kt0 = s_ * u.nt; }
        return true;
    }
};
template <class Epi>
__device__ __forceinline__ void gemm_phase(LAS unsigned char* lds, const bf16_t* gA, const bf16_t* gBt, int M, int N, int K, const Epi& E, float* slab, unsigned* cnt, int G_ = 0, int c_ = 0) {
    const int tid = TID(), wid = __builtin_amdgcn_readfirstlane(tid >> 6), lane = tid & 63, wr = wid >> 2, wc = wid & 3, fr = lane & 15, fq = lane >> 4;
    int sl_ = 0; if constexpr (Epi::PUBLISH) sl_ = E.hidden;
    StaticOrder S; if (G_ > 0) S.init(M, N, K, G_, c_, cnt != nullptr, sl_); else S.init(M, N, K, GDIM(), BID(), cnt != nullptr, sl_);
    unsigned voffA[2], voffB[2];
#pragma unroll
    for (int i = 0; i < 2; ++i) { int R, C; stage_rc(tid * 16 + i * 8192, R, C); const int Rb = Epi::PERM ? ((R & ~31) + perm32(R & 31)) : R;
        voffA[i] = (unsigned)(R * K + C) * 2u; voffB[i] = (unsigned)(Rb * K + C) * 2u; }
    const size_t kstep = (size_t)(BK * 2);
    const size_t hstep = (size_t)HALF * K * 2;
    const size_t tstep = 2 * hstep;
    const unsigned ldsw = (unsigned)wid * 1024u;
    const int aoff = lds_byte(wr * 64 + fr, fq * 8), boff = lds_byte(wc * 32 + fr, fq * 8);
#define PG8_SA(b, h) (((b) * 2 + (h)) * HTB)
#define PG8_SB(b, h) ((4 + (b) * 2 + (h)) * HTB)
#define PG8_STAGE(bufoff, gbase, voff) do { _Pragma("unroll") for (int _i = 0; _i < 2; ++_i) \
        __builtin_amdgcn_global_load_lds((const unsigned*)((const char*)(gbase) + (voff)[_i]), (LAS unsigned*)(lds + (bufoff) + ldsw + _i * 8192), 16, 0, 0); } while (0)
#define PG8_LDA(dst, b, h) do { _Pragma("unroll") for (int m = 0; m < 4; ++m) _Pragma("unroll") for (int k = 0; k < 2; ++k) dst[m][k] = *(const LAS bf16x8*)(lds + PG8_SA(b, h) + aoff + m * 2048 + k * 1024); } while (0)
#define PG8_LDB(dst, b, h) do { _Pragma("unroll") for (int n = 0; n < 2; ++n) _Pragma("unroll") for (int k = 0; k < 2; ++k) dst[n][k] = *(const LAS bf16x8*)(lds + PG8_SB(b, h) + boff + n * 2048 + k * 1024); } while (0)
#define PG8_MMA(ai, bj, At, Bt) do { __builtin_amdgcn_s_setprio(1); _Pragma("unroll") for (int m = 0; m < 4; ++m) _Pragma("unroll") for (int n = 0; n < 2; ++n) _Pragma("unroll") for (int k = 0; k < 2; ++k) \
        acc[ai][bj][m][n] = __builtin_amdgcn_mfma_f32_16x16x32_bf16(Bt[n][k], At[m][k], acc[ai][bj][m][n], 0, 0, 0); __builtin_amdgcn_s_setprio(0); } while (0)
#define PG8_WAIT_V(n) asm volatile("s_waitcnt vmcnt(" #n ")" ::: "memory")
#define PG8_WAIT_L(n) asm volatile("s_waitcnt lgkmcnt(" #n ")" ::: "memory")
#define PG8_BAR __builtin_amdgcn_s_barrier()
#define PG8_SCHED __builtin_amdgcn_sched_barrier(0)
    Unit cur, nxt; int ui = 0;
    if (!S.next(0, cur)) return;
    f32x4 acc[2][2][4][2];
#pragma unroll
    for (int a = 0; a < 2; ++a)
#pragma unroll
        for (int b = 0; b < 2; ++b)
#pragma unroll
            for (int m = 0; m < 4; ++m)
#pragma unroll
                for (int n = 0; n < 2; ++n) acc[a][b][m][n] = (f32x4){0.f, 0.f, 0.f, 0.f};
    bf16x8 At[4][2], B0[2][2], B1[2][2];
    const char* cA = (const char*)gA + (size_t)cur.pm * tstep + (size_t)cur.kt0 * kstep; const char* cB = (const char*)gBt + (size_t)cur.pn * tstep + (size_t)cur.kt0 * kstep;
    PG8_STAGE(PG8_SB(0, 0), cB, voffB); PG8_STAGE(PG8_SB(0, 1), cB + hstep, voffB); PG8_STAGE(PG8_SA(0, 0), cA, voffA); PG8_STAGE(PG8_SA(0, 1), cA + hstep, voffA);
    if (wr == 1) PG8_BAR;
    PG8_WAIT_V(2); PG8_BAR;
    PG8_STAGE(PG8_SB(1, 0), cB + kstep, voffB); PG8_STAGE(PG8_SA(1, 0), cA + kstep, voffA); PG8_STAGE(PG8_SB(1, 1), cB + hstep + kstep, voffB);
    PG8_WAIT_V(6); PG8_BAR;
    for (;;) {
        const bool has_next = S.next(ui + 1, nxt);
        const char* nA = has_next ? (const char*)gA + (size_t)nxt.pm * tstep + (size_t)nxt.kt0 * kstep : cA; const char* nB = has_next ? (const char*)gBt + (size_t)nxt.pn * tstep + (size_t)nxt.kt0 * kstep : cB;
        const int nt = cur.nt;
        for (int t = 0; t < nt; t += 2) {
            const bool last = (t == nt - 2);
            const char* a1 = cA + (size_t)(t + 1) * kstep;
            const char* a2 = last ? nA : cA + (size_t)(t + 2) * kstep; const char* b2 = last ? nB : cB + (size_t)(t + 2) * kstep;
            const char* a3 = a2 + kstep; const char* b3 = b2 + kstep;
            PG8_LDB(B0, 0, 0); PG8_LDB(B1, 0, 1); PG8_SCHED; PG8_LDA(At, 0, 0); PG8_STAGE(PG8_SA(1, 1), a1 + hstep, voffA);
            PG8_WAIT_V(8); PG8_WAIT_L(0); PG8_BAR; PG8_MMA(0, 0, At, B0); PG8_MMA(0, 1, At, B1); PG8_BAR; PG8_SCHED;
            PG8_LDA(At, 0, 1); PG8_STAGE(PG8_SB(0, 0), b2, voffB); PG8_STAGE(PG8_SB(0, 1), b2 + hstep, voffB); PG8_STAGE(PG8_SA(0, 0), a2, voffA);
            PG8_WAIT_V(8); PG8_WAIT_L(0); PG8_BAR; PG8_MMA(1, 0, At, B0); PG8_MMA(1, 1, At, B1); PG8_BAR; PG8_SCHED;
            PG8_LDB(B0, 1, 0); PG8_LDB(B1, 1, 1); PG8_SCHED; PG8_LDA(At, 1, 0); PG8_STAGE(PG8_SA(0, 1), a2 + hstep, voffA);
            PG8_WAIT_V(8); PG8_WAIT_L(0); PG8_BAR; PG8_MMA(0, 0, At, B0); PG8_MMA(0, 1, At, B1); PG8_BAR; PG8_SCHED;
            PG8_LDA(At, 1, 1); PG8_STAGE(PG8_SB(1, 0), b3, voffB); PG8_STAGE(PG8_SB(1, 1), b3 + hstep, voffB); PG8_STAGE(PG8_SA(1, 0), a3, voffA);
            PG8_WAIT_V(8); PG8_WAIT_L(0); PG8_BAR; PG8_MMA(1, 0, At, B0); PG8_MMA(1, 1, At, B1); PG8_BAR; PG8_SCHED;
        }
        if (wr == 0) PG8_BAR;
        int ptu, psl; const bool is_piece = S.piece(ui, ptu, psl);
        if (!is_piece) E(acc, cur, wr, wc, fr, fq);
        else {
            float* sl = slab + (size_t)(ptu * S.S + psl) * 65536 + tid * 4;
#pragma unroll
            for (int a = 0; a < 2; ++a)
#pragma unroll
                for (int b = 0; b < 2; ++b)
#pragma unroll
                    for (int m = 0; m < 4; ++m)
#pragma unroll
                        for (int n = 0; n < 2; ++n) { float* sp_ = sl + (((a * 2 + b) * 4 + m) * 2 + n) * 2048;
                            asm volatile("global_store_dwordx4 %0, %1, off sc1\n\ts_nop 1" :: "v"(sp_), "v"(acc[a][b][m][n]) : "memory"); }
        }
        if constexpr (Epi::PUBLISH) { if (E.hidden && !is_piece) {
            asm volatile("s_waitcnt vmcnt(0)" ::: "memory"); __syncthreads();
            if (tid == 0) (void)__hip_atomic_fetch_add(E.cfull, 1u, __ATOMIC_RELAXED, __HIP_MEMORY_SCOPE_AGENT); } }
        if (!has_next) break;
#pragma unroll
        for (int a = 0; a < 2; ++a)
#pragma unroll
            for (int b = 0; b < 2; ++b)
#pragma unroll
                for (int m = 0; m < 4; ++m)
#pragma unroll
                    for (int n = 0; n < 2; ++n) acc[a][b][m][n] = (f32x4){0.f, 0.f, 0.f, 0.f};
        cur = nxt; cA = nA; cB = nB; ++ui;
        if (wr == 1) PG8_BAR;
    }
    PG8_WAIT_V(0);
    PG8_BAR;
    int ptu, psl;
    if (S.piece(ui, ptu, psl)) {
        const int nS = S.S;
        asm volatile("s_waitcnt vmcnt(0)" ::: "memory");
        __syncthreads();
        if (tid == 0) {
            (void)__hip_atomic_fetch_add(cnt + ptu, 1u, __ATOMIC_RELAXED, __HIP_MEMORY_SCOPE_AGENT);
            unsigned sp = 0;
            while (__hip_atomic_load(cnt + ptu, __ATOMIC_RELAXED, __HIP_MEMORY_SCOPE_AGENT) < (unsigned)nS && ++sp < (1u << 24)) __builtin_amdgcn_s_sleep(1);
            __builtin_amdgcn_fence(__ATOMIC_ACQUIRE, "agent");
            asm volatile("s_waitcnt vmcnt(0)" ::: "memory");
        }
        __syncthreads();
        const int q0 = (nS == 2) ? 2 * psl : psl, q1 = (nS == 2) ? 2 * psl + 1 : ((nS == 3 && psl == 0) ? 3 : -1);
        for (int qi = 0; qi < 2; ++qi) { const int qq = qi ? q1 : q0; if (qq < 0) break;
            QuarT q;
#pragma unroll
            for (int m = 0; m < 4; ++m)
#pragma unroll
                for (int n = 0; n < 2; ++n) q[m][n] = (f32x4){0.f, 0.f, 0.f, 0.f};
            for (int s2 = 0; s2 < nS; ++s2) { const float* sl = slab + (size_t)(ptu * nS + s2) * 65536 + (size_t)qq * 8 * 2048 + tid * 4;
#pragma unroll
                for (int m = 0; m < 4; ++m)
#pragma unroll
                    for (int n = 0; n < 2; ++n) q[m][n] += *(const f32x4*)(sl + (m * 2 + n) * 2048); }
            E.quarter(q, cur, qq >> 1, qq & 1, wr, wc, fr, fq);
        }
        if constexpr (Epi::PUBLISH) asm volatile("s_waitcnt vmcnt(0)" ::: "memory");
        __syncthreads();
        if constexpr (Epi::PUBLISH) { if (E.hidden && tid == 0) (void)__hip_atomic_fetch_add(E.cpiece, 1u, __ATOMIC_RELAXED, __HIP_MEMORY_SCOPE_AGENT); }
    }
#undef PG8_SA
#undef PG8_SB
#undef PG8_STAGE
#undef PG8_LDA
#undef PG8_LDB
#undef PG8_MMA
#undef PG8_WAIT_V
#undef PG8_WAIT_L
#undef PG8_BAR
#undef PG8_SCHED
}
}
using pg8::Unit;
typedef f32x4 AccT[2][2][4][2];

#define EPI_ALL_QUARTERS \
    __device__ __forceinline__ void operator()(const AccT& acc, const Unit& u, int wr, int wc, int fr, int fq) const { \
        _Pragma("unroll") for (int ai = 0; ai < 2; ++ai) _Pragma("unroll") for (int bj = 0; bj < 2; ++bj) { quarter(acc[ai][bj], u, ai, bj, wr, wc, fr, fq); __builtin_amdgcn_sched_barrier(0); } }
struct EpiAda {
    static constexpr bool PERM = false, PUBLISH = false;
    float* C; const float* bias;
    __device__ __forceinline__ void quarter(const QuarT& q, const Unit& u, int ai, int bj, int wr, int wc, int fr, int fq) const {
        const int row0 = u.pm * 256 + ai * 128 + wr * 64 + fr, col0 = u.pn * 256 + bj * 128 + wc * 32 + 4 * fq;
        const f32x4 b0 = *(const f32x4*)(bias + col0), b1 = *(const f32x4*)(bias + col0 + 16);
#pragma unroll
        for (int m = 0; m < 4; ++m) { float* rowp = C + (size_t)(row0 + m * 16) * 24576 + col0; *(f32x4*)rowp = q[m][0] + b0; *(f32x4*)(rowp + 16) = q[m][1] + b1; }
    }
    EPI_ALL_QUARTERS
};
struct EpiProj {
    static constexpr bool PERM = true, PUBLISH = false;
    bf16_t* O; const float* bias;
    __device__ __forceinline__ void quarter(const QuarT& q, const Unit& u, int ai, int bj, int wr, int wc, int fr, int fq) const {
        const int row0 = u.pm * 256 + ai * 128 + wr * 64 + fr, colt = u.pn * 256, col0 = colt + bj * 128 + wc * 32 + 8 * fq;
        const int mode = (colt >= 6144) ? 2 : (((colt >= 1024 && colt < 2048) || colt >= 4096) ? 1 : 0);
        const f32x4 b0 = *(const f32x4*)(bias + col0), b1 = *(const f32x4*)(bias + col0 + 4);
#pragma unroll
        for (int m = 0; m < 4; ++m) { f32x4 v0 = q[m][0] + b0, v1 = q[m][1] + b1;
            if (mode) {
#pragma unroll
                for (int e = 0; e < 4; ++e) { const float s0 = sigm(v0[e]), s1 = sigm(v1[e]); v0[e] = (mode == 2) ? s0 : v0[e] * s0; v1[e] = (mode == 2) ? s1 : v1[e] * s1; } }
            u32x4 o; o.x = pk2(v0[0], v0[1]); o.y = pk2(v0[2], v0[3]); o.z = pk2(v1[0], v1[1]); o.w = pk2(v1[2], v1[3]);
            *(u32x4*)(O + (size_t)(row0 + m * 16) * INC + col0) = o; }
    }
    EPI_ALL_QUARTERS
};
struct EpiGlu {
    static constexpr bool PERM = true, PUBLISH = false;
    bf16_t* O; const bf16_t* Y; const bf16_t* PROJ; const float* bias;
    __device__ __forceinline__ void quarter(const QuarT& q, const Unit& u, int ai, int bj, int wr, int wc, int fr, int fq) const {
        const int row0 = u.pm * 256 + ai * 128 + wr * 64 + fr, col = u.pn * 256 + bj * 128 + wc * 32 + 8 * fq;
        const f32x4 b0 = *(const f32x4*)(bias + col), b1 = *(const f32x4*)(bias + col + 4);
#pragma unroll
        for (int m = 0; m < 4; ++m) { const size_t row = (size_t)(row0 + m * 16);
            const u32x4 yv = *(const u32x4*)(Y + row * S5W + col), zv = *(const u32x4*)(PROJ + row * INC + 1024 + col);
            const f32x4 v0 = q[m][0] + b0, v1 = q[m][1] + b1;
            u32x4 o;
            o.x = pk2(bflo(yv.x) * sigm(v0[0]) * bflo(zv.x), bfhi(yv.x) * sigm(v0[1]) * bfhi(zv.x));
            o.y = pk2(bflo(yv.y) * sigm(v0[2]) * bflo(zv.y), bfhi(yv.y) * sigm(v0[3]) * bfhi(zv.y));
            o.z = pk2(bflo(yv.z) * sigm(v1[0]) * bflo(zv.z), bfhi(yv.z) * sigm(v1[1]) * bfhi(zv.z));
            o.w = pk2(bflo(yv.w) * sigm(v1[2]) * bflo(zv.w), bfhi(yv.w) * sigm(v1[3]) * bfhi(zv.w));
            { bf16_t* yo_ = O + row * S5W + col; asm volatile("global_store_dwordx4 %0, %1, off sc1\n\ts_nop 1" :: "v"(yo_), "v"(o) : "memory"); } }
    }
    EPI_ALL_QUARTERS
};
struct EpiPa {
    static constexpr bool PERM = true, PUBLISH = false;
    bf16_t* T; const bf16_t* PROJ; int goff;
    __device__ __forceinline__ void quarter(const QuarT& q, const Unit& u, int ai, int bj, int wr, int wc, int fr, int fq) const {
        const int row0 = u.pm * 256 + ai * 128 + wr * 64 + fr, col = u.pn * 256 + bj * 128 + wc * 32 + 8 * fq;
#pragma unroll
        for (int m = 0; m < 4; ++m) { const size_t row = (size_t)(row0 + m * 16);
            const u32x4 g = *(const u32x4*)(PROJ + row * INC + goff + col);
            const f32x4 a0 = q[m][0], a1 = q[m][1];
            u32x4 o; o.x = pk2(bflo(g.x) * a0[0], bfhi(g.x) * a0[1]); o.y = pk2(bflo(g.y) * a0[2], bfhi(g.y) * a0[3]);
            o.z = pk2(bflo(g.z) * a1[0], bfhi(g.z) * a1[1]); o.w = pk2(bflo(g.w) * a1[2], bfhi(g.w) * a1[3]);
            *(u32x4*)(T + row * D + col) = o; }
    }
    EPI_ALL_QUARTERS
};
struct EpiPb {
    static constexpr bool PERM = true, PUBLISH = false;
    bf16_t* O; const bf16_t* T; const bf16_t* PROJ; int goff;
    __device__ __forceinline__ void quarter(const QuarT& q, const Unit& u, int ai, int bj, int wr, int wc, int fr, int fq) const {
        const int row0 = u.pm * 256 + ai * 128 + wr * 64 + fr, col = u.pn * 256 + bj * 128 + wc * 32 + 8 * fq;
#pragma unroll
        for (int m = 0; m < 4; ++m) { const size_t row = (size_t)(row0 + m * 16);
            const u32x4 g = *(const u32x4*)(PROJ + row * INC + goff + col), t = *(const u32x4*)(T + row * D + col);
            const f32x4 a0 = q[m][0], a1 = q[m][1];
            u32x4 o;
            o.x = pk2(bflo(t.x) + bflo(g.x) * a0[0], bfhi(t.x) + bfhi(g.x) * a0[1]); o.y = pk2(bflo(t.y) + bflo(g.y) * a0[2], bfhi(t.y) + bfhi(g.y) * a0[3]);
            o.z = pk2(bflo(t.z) + bflo(g.z) * a1[0], bfhi(t.z) + bfhi(g.z) * a1[1]); o.w = pk2(bflo(t.w) + bflo(g.w) * a1[2], bfhi(t.w) + bfhi(g.w) * a1[3]);
            *(u32x4*)(O + row * D + col) = o; }
    }
    EPI_ALL_QUARTERS
};
struct EpiOut {
    static constexpr bool PERM = true, PUBLISH = true;
    bf16_t* X; const float* xp; const float* xs; const float* ada_gate; int first;
    int hidden; unsigned* cfull; unsigned* cpiece;
    __device__ __forceinline__ void quarter(const QuarT& q, const Unit& u, int ai, int bj, int wr, int wc, int fr, int fq) const {
        const int row0 = u.pm * 256 + ai * 128 + wr * 64 + fr, col = u.pn * 256 + bj * 128 + wc * 32 + 8 * fq;
#pragma unroll
        for (int m = 0; m < 4; ++m) { const int row = row0 + m * 16;
            f32x4 x0, x1;
            if (first) { const float* xin = row < NP ? xp + (size_t)row * D : xs + (size_t)(row - NP) * D; x0 = *(const f32x4*)(xin + col); x1 = *(const f32x4*)(xin + col + 4); }
            else { const u32x4 w = *(const u32x4*)(X + (size_t)row * D + col); x0 = (f32x4){bflo(w.x), bfhi(w.x), bflo(w.y), bfhi(w.y)}; x1 = (f32x4){bflo(w.z), bfhi(w.z), bflo(w.w), bfhi(w.w)}; }
            const float* gp = ada_gate + (size_t)row_b(row) * 24576;
            x0 += *(const f32x4*)(gp + col) * q[m][0]; x1 += *(const f32x4*)(gp + col + 4) * q[m][1];
            { bf16_t* xo_ = X + (size_t)row * D + col; const u32x4 ov_ = (u32x4){pk2(x0[0], x0[1]), pk2(x0[2], x0[3]), pk2(x1[0], x1[1]), pk2(x1[2], x1[3])};
              asm volatile("global_store_dwordx4 %0, %1, off sc1\n\ts_nop 1" :: "v"(xo_), "v"(ov_) : "memory"); } }
    }
    EPI_ALL_QUARTERS
};

struct TItem { const float* src; bf16_t* dst; int N, K; };
constexpr int TI_ADA = 4 * 3072, TI_LAYER = 5120 + 256 + 512 + 1024 + 1024 + 64 + 64;
__device__ __forceinline__ TItem tdecode(KP& p, int L, int r) {
    const float* W; bf16_t* WT; int K, N, inst = 0; size_t dsto = 0, srco = 0;
    if (L < 0) { W = p.in[I_WADA]; WT = (bf16_t*)(p.ws + WS_WT_ADA); K = 2048; N = 6144; inst = r / 3072; r %= 3072; dsto = srco = (size_t)inst * K * N; }
    else if (r < 5120) { W = p.in[I_WIN]; WT = (bf16_t*)(p.ws + WS_WT_IN); K = 2048; N = INC; dsto = srco = (size_t)L * K * N; }
    else if ((r -= 5120) < 256) { W = p.in[I_WGLU]; WT = (bf16_t*)(p.ws + WS_WT_GLU); K = 1024; N = 1024; dsto = srco = (size_t)L * K * N; }
    else if ((r -= 256) < 512) { W = p.in[I_WPA]; WT = (bf16_t*)(p.ws + WS_WT_PA); K = 1024; N = 2048; dsto = srco = (size_t)L * K * N; }
    else if ((r -= 512) < 1024) { W = p.in[I_WPB]; WT = (bf16_t*)(p.ws + WS_WT_PB); K = 2048; N = 2048; dsto = srco = (size_t)L * K * N; }
    else if ((r -= 1024) < 1024) { W = p.in[I_WOUT]; WT = (bf16_t*)(p.ws + WS_WT_OUT); K = 2048; N = 2048; dsto = srco = (size_t)L * K * N; }
    else if ((r -= 1024) < 64) { W = p.in[I_WR]; WT = (bf16_t*)(p.ws + WS_WT_RG); K = 128; N = 128; inst = r / 4; r %= 4; srco = (size_t)(L * 16 + inst) * 16384; dsto = ((size_t)L * 2 + 0) * 262144 + (size_t)inst * 16384; }
    else { r -= 64; W = p.in[I_WI]; WT = (bf16_t*)(p.ws + WS_WT_RG); K = 128; N = 128; inst = r / 4; r %= 4; srco = (size_t)(L * 16 + inst) * 16384; dsto = ((size_t)L * 2 + 1) * 262144 + (size_t)inst * 16384; }
    const int nb_n = N / 64, kb = r / nb_n, nb = r % nb_n;
    TItem t; t.N = N; t.K = K; t.src = W + srco + (size_t)(kb * 64) * N + nb * 64; t.dst = WT + dsto + (size_t)(nb * 64) * K + kb * 64; return t;
}
__device__ __forceinline__ void transpose_set(KP& p, LAS unsigned char* lds, int L, int w, int nw, int first = 0, int count = -1) {
    const int lane = TID() & 63, wave = TID() >> 6;
    const int nitems = count < 0 ? (L < 0 ? TI_ADA : TI_LAYER) : first + count;
    LAS float* tile = (LAS float*)(lds + wave * 16640);
    int it = first + w; if (it >= nitems) return;
    TItem cur = tdecode(p, L, it);
    f32x4 v[16];
#pragma unroll
    for (int i = 0; i < 16; ++i) v[i] = *(const f32x4*)(cur.src + (size_t)((lane >> 4) + 4 * i) * cur.N + (lane & 15) * 4);
    for (;;) {
#pragma unroll
        for (int i = 0; i < 16; ++i) { LAS float* d = tile + ((lane >> 4) + 4 * i) * 65 + (lane & 15) * 4; d[0] = v[i][0]; d[1] = v[i][1]; d[2] = v[i][2]; d[3] = v[i][3]; }
        const int nit = it + nw; const bool more = nit < nitems; TItem nx = cur;
        if (more) { nx = tdecode(p, L, nit);
#pragma unroll
            for (int i = 0; i < 16; ++i) v[i] = *(const f32x4*)(nx.src + (size_t)((lane >> 4) + 4 * i) * nx.N + (lane & 15) * 4); }
        LDS_WAIT();
        const int c = lane & 7;
#pragma unroll
        for (int j = 0; j < 8; ++j) { const int n = (lane >> 3) + 8 * j; const LAS float* sp = tile + (8 * c) * 65 + n;
            u32x4 o; o.x = pk2(sp[0], sp[65]); o.y = pk2(sp[2 * 65], sp[3 * 65]); o.z = pk2(sp[4 * 65], sp[5 * 65]); o.w = pk2(sp[6 * 65], sp[7 * 65]);
            *(u32x4*)(cur.dst + (size_t)n * cur.K + 8 * c) = o; }
        LDS_WAIT();
        if (!more) break;
        cur = nx; it = nit;
    }
}

__device__ __forceinline__ void sincos_d(double x, double& s, double& c) {
    const double k = rint(x * 0.15915494309189535); const double r = x - k * 6.283185307179586476925; const double r2 = r * r;
    double as = 1.0, ac = 1.0;
#pragma unroll
    for (int n = 14; n >= 1; --n) { as = 1.0 - r2 * (1.0 / ((2.0 * n) * (2.0 * n + 1.0))) * as; ac = 1.0 - r2 * (1.0 / ((2.0 * n - 1.0) * (2.0 * n))) * ac; }
    s = r * as; c = ac;
}

__device__ __forceinline__ void phase_prologue(KP& p, LAS unsigned char* lds) {
    const int tid = TID(), lane = tid & 63, wave = tid >> 6;
    const int gw = BID() * 8 + wave, NGW = GDIM() * 8;
    for (int i = BID() * 512 + tid; i < 4 * 4096; i += GDIM() * 512) {
        const int lg = i >> 6;
        const float lr = p.in[I_LAMRE][i], li = p.in[I_LAMIM][i], dt = expf(p.in[I_LOGDT][lg]);
        const float mag = expf(lr * dt); double sd, cd; sincos_d((double)li * (double)dt, sd, cd);
        const float are = mag * (float)cd, aim = mag * (float)sd;
        float pr = are, pi = aim;
#pragma unroll
        for (int s = 0; s < 6; ++s) { const float nr = pr * pr - pi * pi, ni = 2.f * pr * pi; pr = nr; pi = ni; }
        *(f32x4*)(p.ws + WS_S5ABAR + (size_t)i * 16) = (f32x4){are, aim, pr, pi};
        const float nr = are - 1.f, ni = aim, den = lr * lr + li * li;
        const float cre = (nr * lr + ni * li) / den, cim = (ni * lr - nr * li) / den;
        const float* bre = p.in[I_BRE] + (size_t)i * 16; const float* bim = p.in[I_BIM] + (size_t)i * 16;
        bf16_t* bbf = (bf16_t*)(p.ws + WS_S5BBR);
        const int pst = i & 63;
#pragma unroll
        for (int c4 = 0; c4 < 4; ++c4) { const f32x4 br = *(const f32x4*)(bre + 4 * c4), bi = *(const f32x4*)(bim + 4 * c4);
            const f32x4 vr = cre * br - cim * bi, vi = cre * bi + cim * br;
#pragma unroll
            for (int e = 0; e < 4; ++e) { const int c = 4 * c4 + e, half = c >> 3, j = c & 7;
#pragma unroll
                for (int part = 0; part < 2; ++part) { const int n = 2 * pst + part, nb = n >> 4, nl = n & 15;
                    bbf[((size_t)(lg * 8 + nb) * 32 + half * 16 + nl) * 8 + j] = (bf16_t)(pk2(part ? vi[e] : vr[e], 0.f) & 0xffffu); } } }
    }
    for (int i = BID() * 512 + tid; i < 256 * D / 4; i += GDIM() * 512) {
        const int row = i >> 9, c4 = (i & 511) * 4;
        f32x4 v = (f32x4){0.f, 0.f, 0.f, 0.f};
        if (row < 4) v = *(const f32x4*)(p.in[I_CP] + (size_t)row * D + c4); else if (row < 132) v = *(const f32x4*)(p.in[I_CS] + (size_t)(row - 4) * D + c4);
        *(u32x2*)(p.ws + WS_CB + ((size_t)row * D + c4) * 2) = (u32x2){pk2(v[0], v[1]), pk2(v[2], v[3])};
    }
    transpose_set(p, lds, -1, gw, NGW);
    if (GDIM() != 256) transpose_set(p, lds, 0, gw, NGW); else transpose_set(p, lds, 0, gw, NGW, 0, 5120);
}

__device__ __forceinline__ void phase_norm(KP& p, int l, bool final_norm, int w0 = -1, int nw = 0, int r0 = 0, int r1 = MR) {
    const int lane = TID() & 63, wave = TID() >> 6;
    const float* ada = (const float*)(p.ws + WS_ADA);
    const bool from_in = !final_norm && l == 0;
    if (w0 < 0) { w0 = BID() * 8 + wave; nw = GDIM() * 8; }
    for (int row = r0 + w0; row < r1; row += nw) {
        f32x4 v[8]; float ss = 0.f;
        if (from_in) { const float* xr = row < NP ? p.in[I_XP] + (size_t)row * D : p.in[I_XS] + (size_t)(row - NP) * D;
#pragma unroll
            for (int j = 0; j < 8; ++j) v[j] = *(const f32x4*)(xr + (lane + 64 * (j >> 1)) * 8 + (j & 1) * 4); }
        else { const bf16_t* xr = (const bf16_t*)(p.ws + WS_X) + (size_t)row * D;
#pragma unroll
            for (int j2 = 0; j2 < 4; ++j2) { const u32x4 w = *(const u32x4*)(xr + (lane + 64 * j2) * 8);
                v[2 * j2] = (f32x4){bflo(w.x), bfhi(w.x), bflo(w.y), bfhi(w.y)}; v[2 * j2 + 1] = (f32x4){bflo(w.z), bfhi(w.z), bflo(w.w), bfhi(w.w)}; } }
#pragma unroll
        for (int j = 0; j < 8; ++j) ss += (v[j][0] * v[j][0] + v[j][1] * v[j][1]) + (v[j][2] * v[j][2] + v[j][3] * v[j][3]);
        const float rstd = 1.0f / sqrtf(wave_sum(ss) * (1.f / D) + EPS);
        if (final_norm) {
#pragma unroll
            for (int j = 0; j < 8; ++j) { const int c = (lane + 64 * (j >> 1)) * 8 + (j & 1) * 4; *(f32x4*)(p.out + (size_t)row * D + c) = v[j] * rstd * *(const f32x4*)(p.in[I_FG] + c); }
        } else {
            const float* ar = ada + (size_t)row_b(row) * 24576 + l * 6144; const float* ng = p.in[I_NG] + l * D;
            bf16_t* xo = (bf16_t*)(p.ws + WS_XN) + (size_t)row * D;
#pragma unroll
            for (int j2 = 0; j2 < 4; ++j2) { const int c = (lane + 64 * j2) * 8;
                const f32x4 y0 = v[2 * j2] * rstd * *(const f32x4*)(ng + c) * (1.f + *(const f32x4*)(ar + 2048 + c)) + *(const f32x4*)(ar + c);
                const f32x4 y1 = v[2 * j2 + 1] * rstd * *(const f32x4*)(ng + c + 4) * (1.f + *(const f32x4*)(ar + 2048 + c + 4)) + *(const f32x4*)(ar + c + 4);
                *(u32x4*)(xo + c) = (u32x4){pk2(y0[0], y0[1]), pk2(y0[2], y0[3]), pk2(y1[0], y1[1]), pk2(y1[2], y1[3])}; }
        }
    }
}

constexpr int S5_BU = 0, S5_HB = 8448, S5_YB = 8448 + 5376, S5_WAVE_BYTES = 8448 + 5376 + 2048;
template <bool OUT>
__device__ __forceinline__ void phase_s5(KP& p, int l, LAS unsigned char* lds) {
    const int lane = TID() & 63, wave = __builtin_amdgcn_readfirstlane(TID() >> 6), fr = lane & 15, fq = lane >> 4;
    LAS float* bu = (LAS float*)(lds + wave * S5_WAVE_BYTES + S5_BU);
    LAS unsigned char* hb = lds + wave * S5_WAVE_BYTES + S5_HB;
    LAS bf16_t* yb = (LAS bf16_t*)(lds + wave * S5_WAVE_BYTES + S5_YB);
    const bf16_t* PROJ = (const bf16_t*)(p.ws + WS_PROJ);
    if (OUT) { if (lane < 16) { *(LAS u32x4*)(hb + lane * 336 + 288) = (u32x4){0u, 0u, 0u, 0u}; *(LAS u32x4*)(hb + lane * 336 + 304) = (u32x4){0u, 0u, 0u, 0u}; } }
    const int nitems = OUT ? NTILE * 64 : 128 * 64;
    int gprev = -1;
    bf16x8 bf[8]; f32x4 ab = (f32x4){0.f, 0.f, 0.f, 0.f}; bf16x8 cf[5];
    for (int it = BID() * 8 + wave; it < nitems; it += GDIM() * 8) {
        const int tI = it >> 6, g = it & 63; const bool prompt = tI < 128; const int row0 = tI * 64;
        if (g != gprev) { gprev = g;
#pragma unroll
        for (int nb = 0; nb < 8; ++nb) { u32x4 w = (u32x4){0u, 0u, 0u, 0u};
            if (lane < 32) w = *(const u32x4*)(p.ws + WS_S5BBR + ((size_t)((l * 64 + g) * 8 + nb) * 32 + lane) * 16);
            bf[nb] = __builtin_bit_cast(bf16x8, w); }
        ab = *(const f32x4*)(p.ws + WS_S5ABAR + ((size_t)(l * 64 + g) * 64 + lane) * 16);
        if (OUT) { const float* cre = p.in[I_CRE] + (((size_t)l * 64 + g) * 16 + fr) * 64; const float* cim = p.in[I_CIM] + (((size_t)l * 64 + g) * 16 + fr) * 64;
#pragma unroll
            for (int kk = 0; kk < 4; ++kk) { const f32x4 a = *(const f32x4*)(cre + 16 * kk + 4 * fq), b = *(const f32x4*)(cim + 16 * kk + 4 * fq);
                u32x4 w; w.x = pk2(a[0], -b[0]); w.y = pk2(a[1], -b[1]); w.z = pk2(a[2], -b[2]); w.w = pk2(a[3], -b[3]);
                cf[kk] = __builtin_bit_cast(bf16x8, w); }
            const float dval = p.in[I_S5D][l * S5W + g * 16 + fr];
            const unsigned dbf = pk2(dval, 0.f) & 0xffffu; const int jj = fr & 7; const bool mine = (fq == (fr >> 3));
            u32x4 w; w.x = (mine && (jj >> 1) == 0) ? (dbf << (16 * (jj & 1))) : 0u; w.y = (mine && (jj >> 1) == 1) ? (dbf << (16 * (jj & 1))) : 0u;
            w.z = (mine && (jj >> 1) == 2) ? (dbf << (16 * (jj & 1))) : 0u; w.w = (mine && (jj >> 1) == 3) ? (dbf << (16 * (jj & 1))) : 0u;
            cf[4] = __builtin_bit_cast(bf16x8, w); }
        }
        float hr = 0.f, hi = 0.f;
        if (OUT && prompt) { const int b = tI >> 5, k = tI & 31;
            const float* lr = (const float*)(p.ws + WS_S5LOCR) + (size_t)(b * 32) * 4096 + g * 64 + lane; const float* li = (const float*)(p.ws + WS_S5LOCI) + (size_t)(b * 32) * 4096 + g * 64 + lane;
            for (int jb = 0; jb < k; jb += 8) { float sr[8], si[8];
#pragma unroll
                for (int u = 0; u < 8; ++u) { const int j = (jb + u) < 31 ? (jb + u) : 31; sr[u] = lr[(size_t)j * 4096]; si[u] = li[(size_t)j * 4096]; }
#pragma unroll
                for (int u = 0; u < 8; ++u) { const float nr = ab[2] * hr - ab[3] * hi + sr[u], ni = ab[2] * hi + ab[3] * hr + si[u]; const bool on = (jb + u) < k; hr = on ? nr : hr; hi = on ? ni : hi; } } }
        u32x4 unext = (u32x4){0u, 0u, 0u, 0u};
        if (lane < 32) unext = *(const u32x4*)(PROJ + (size_t)(row0 + fr) * INC + g * 16 + 8 * fq);
        for (int sub = 0; sub < 4; ++sub) {
            const u32x4 uw = unext;
            if (sub < 3 && lane < 32) unext = *(const u32x4*)(PROJ + (size_t)(row0 + (sub + 1) * 16 + fr) * INC + g * 16 + 8 * fq);
            const bf16x8 ua = __builtin_bit_cast(bf16x8, uw);
            f32x4 dd[8];
#pragma unroll
            for (int nb = 0; nb < 8; ++nb) dd[nb] = __builtin_amdgcn_mfma_f32_16x16x32_bf16(ua, bf[nb], (f32x4){0.f, 0.f, 0.f, 0.f}, 0, 0, 0);
            asm volatile("s_nop 15\n\ts_nop 15" : "+v"(dd[0]), "+v"(dd[1]), "+v"(dd[2]), "+v"(dd[3]), "+v"(dd[4]), "+v"(dd[5]), "+v"(dd[6]), "+v"(dd[7]));
#pragma unroll
            for (int nb = 0; nb < 8; ++nb)
#pragma unroll
                for (int r = 0; r < 4; ++r) bu[(4 * fq + r) * 132 + 16 * nb + fr] = dd[nb][r];
            if (OUT) { if (lane < 32) *(LAS u32x4*)(hb + fr * 336 + (128 + 8 * fq) * 2) = uw; }
            LDS_WAIT();
#pragma unroll
            for (int tt = 0; tt < 16; ++tt) { const int t = sub * 16 + tt;
                if (OUT) { if (!prompt && (t & 3) == 0) { const size_t si = (((size_t)l * 128 + (tI - 128) * 16 + (t >> 2)) * 64 + g) * 64 + lane; hr = p.in[I_S5RE][si]; hi = p.in[I_S5IM][si]; } }
                const f32x2 bv = *(const LAS f32x2*)(bu + tt * 132 + 2 * lane);
                const float nr = ab[0] * hr - ab[1] * hi + bv[0], ni = ab[0] * hi + ab[1] * hr + bv[1]; hr = nr; hi = ni;
                if (OUT) { *(LAS unsigned*)(hb + tt * 336 + lane * 4) = pk2(hr, hi);
                    if (!prompt && (t & 3) == 3) { const size_t si = (((size_t)l * 128 + (tI - 128) * 16 + (t >> 2)) * 64 + g) * 64 + lane; p.out[O_S5RS + si] = hr; p.out[O_S5IS + si] = hi; } }
            }
            if (OUT) {
                LDS_WAIT();
                f32x4 acc = (f32x4){0.f, 0.f, 0.f, 0.f};
#pragma unroll
                for (int kk = 0; kk < 5; ++kk) { const bf16x8 a = *(const LAS bf16x8*)(hb + fr * 336 + (32 * kk + 8 * fq) * 2); acc = __builtin_amdgcn_mfma_f32_16x16x32_bf16(a, cf[kk], acc, 0, 0, 0); }
                asm volatile("s_nop 15" : "+v"(acc));
#pragma unroll
                for (int r = 0; r < 4; ++r) { const int t = sub * 16 + fq * 4 + r; float y = acc[r];
                    { const float tq = __builtin_amdgcn_rcpf(__builtin_fabsf(y) * 0.2316418882f + 1.0f);
                      float q = tq * 0.5307027145f + (-0.7265760135f); q = q * tq + 0.7107068705f; q = q * tq + (-0.142248368f); q = q * tq + 0.127414796f; q = q * tq;
                      const float m = y * (q * __builtin_amdgcn_exp2f(y * y * (-0.72134752044f))); y = y < 0.f ? m : y - m; }
                    yb[t * 16 + fr] = (bf16_t)(pk2(y, 0.f) & 0xffffu); }
            }
            LDS_WAIT();
        }
        if (OUT) {
            if (prompt && (tI & 31) == 31) { const size_t si = (((size_t)l * 4 + (tI >> 5)) * 64 + g) * 64 + lane; p.out[O_S5RP + si] = hr; p.out[O_S5IP + si] = hi; }
            const LAS u32x4* sy = (const LAS u32x4*)(yb + lane * 16); const u32x4 o0 = sy[0], o1 = sy[1];
            u32x4* d = (u32x4*)((bf16_t*)(p.ws + WS_YS5) + (size_t)(row0 + lane) * S5W + g * 16); d[0] = o0; d[1] = o1;
            LDS_WAIT();
        } else {
            ((float*)(p.ws + WS_S5LOCR))[(size_t)tI * 4096 + g * 64 + lane] = hr;
            ((float*)(p.ws + WS_S5LOCI))[(size_t)tI * 4096 + g * 64 + lane] = hi;
        }
    }
}

constexpr int RG_WL = 0, RG_AT = 69632, RG_AB = 87040, RG_BB = 120832;
__device__ __forceinline__ void phase_rg_local(KP& p, int l, LAS unsigned char* lds) {
    const int tid = TID(), lane = tid & 63, wave = tid >> 6, fr = lane & 15, fq = lane >> 4;
    const int nbh = GDIM() >> 4; if (BID() >= nbh * 16) return;
    const int h = BID() & 15;
    const bf16_t* PROJ = (const bf16_t*)(p.ws + WS_PROJ);
    bf16_t* YB = (bf16_t*)(p.ws + WS_YB); bf16_t* PBUF = (bf16_t*)(p.ws + WS_PB);
    { const bf16_t* w = (const bf16_t*)(p.ws + WS_WT_RG) + (size_t)l * 2 * 262144 + (size_t)h * 16384;
#pragma unroll
        for (int gsel = 0; gsel < 2; ++gsel)
#pragma unroll
            for (int i = 0; i < 4; ++i) { const int idx = tid + 512 * i, n = idx >> 4, kc = (idx & 15) * 8;
                *(LAS u32x4*)(lds + RG_WL + gsel * 34816 + n * 272 + kc * 2) = *(const u32x4*)(w + (size_t)gsel * 262144 + n * 128 + kc); } }
    const int cp = tid & 63, rg = tid >> 6, chg2 = h * 128 + 2 * cp;
    f32x2 cw[4];
#pragma unroll
    for (int k = 0; k < 4; ++k) cw[k] = *(const f32x2*)(p.in[I_CW] + (size_t)(l * 4 + k) * D + chg2);
    const f32x2 cbias = *(const f32x2*)(p.in[I_CBIAS] + (size_t)l * D + chg2);
    const int mt = (wave & 3) * 16, ch0 = (wave >> 2) * 64;
    float sp8[4], brr[4], bii[4];
#pragma unroll
    for (int nt = 0; nt < 4; ++nt) { const int cg_ = h * 128 + ch0 + nt * 16 + fr; brr[nt] = p.in[I_BR][l * D + cg_]; bii[nt] = p.in[I_BI][l * D + cg_]; sp8[nt] = -8.f * log1pf(expf(-p.in[I_LAM][l * D + cg_])); }
    LAS unsigned char* At = lds + RG_AT; LAS float* abuf = (LAS float*)(lds + RG_AB); LAS float* bbuf = (LAS float*)(lds + RG_BB);
    u32x4 xq[3];
#define RG_PREFETCH(t) { _Pragma("unroll") for (int i = 0; i < 3; ++i) { const int idx = tid + 512 * i, row = (idx >> 4) - 3, chunk = idx & 15; \
        const bool ok = idx < 1072 && (row >= 0 || ((t) < 128 && ((t) & 31) > 0)); xq[i] = (u32x4){0u, 0u, 0u, 0u}; \
        if (ok) xq[i] = *(const u32x4*)(PROJ + (size_t)((t) * 64 + row) * INC + 2048 + h * 128 + chunk * 8); } }
    int tI = BID() >> 4;
    if (tI < NTILE) RG_PREFETCH(tI);
    for (; tI < NTILE; tI += nbh) {
        const bool prompt = tI < 128; const int row0 = tI * 64;
#pragma unroll
        for (int i = 0; i < 3; ++i) { const int idx = tid + 512 * i; if (idx < 1072) *(LAS u32x4*)(lds + RG_BB + idx * 16) = xq[i]; }
        { const int nI = tI + nbh; if (nI < NTILE) RG_PREFETCH(nI); }
        __syncthreads();
        {
            const LAS unsigned* xr = (const LAS unsigned*)(lds + RG_BB) + cp;
            unsigned w = xr[(8 * rg + 0) * 64]; f32x2 m3 = (f32x2){bflo(w), bfhi(w)}; w = xr[(8 * rg + 1) * 64]; f32x2 m2 = (f32x2){bflo(w), bfhi(w)}; w = xr[(8 * rg + 2) * 64]; f32x2 m1 = (f32x2){bflo(w), bfhi(w)};
#pragma unroll
            for (int i = 0; i < 8; ++i) { const int r = 8 * rg + i; const int bs = (tI - 128) * 16 + (r >> 2);
                if (!prompt && (i & 3) == 0) { const float* cb = p.in[I_CONV] + ((size_t)(l * 128 + bs) * 3) * D + chg2; m3 = *(const f32x2*)cb; m2 = *(const f32x2*)(cb + D); m1 = *(const f32x2*)(cb + 2 * D); }
                w = xr[(r + 3) * 64]; const f32x2 x = (f32x2){bflo(w), bfhi(w)};
                const f32x2 cv = cbias + cw[0] * m3 + cw[1] * m2 + cw[2] * m1 + cw[3] * x;
                *(LAS unsigned*)(At + r * 272 + cp * 4) = pk2(cv[0], cv[1]);
                if (prompt) { if ((tI & 31) == 31 && r >= 61) *(f32x2*)(p.out + O_CONVP + ((size_t)(l * 4 + (tI >> 5)) * 3 + (r - 61)) * D + chg2) = x; }
                else if ((i & 3) != 0) *(f32x2*)(p.out + O_CONVS + ((size_t)(l * 128 + bs) * 3 + ((i & 3) - 1)) * D + chg2) = x;
                m3 = m2; m2 = m1; m1 = x; }
        }
        __syncthreads();
        {
            bf16x8 a[4];
#pragma unroll
            for (int kk = 0; kk < 4; ++kk) a[kk] = *(const LAS bf16x8*)(At + (mt + fr) * 272 + (32 * kk + 8 * fq) * 2);
#pragma unroll
            for (int nt = 0; nt < 4; ++nt) {
                f32x4 ar = (f32x4){0.f, 0.f, 0.f, 0.f}, ai = (f32x4){0.f, 0.f, 0.f, 0.f};
#pragma unroll
                for (int kk = 0; kk < 4; ++kk) {
                    const bf16x8 br = *(const LAS bf16x8*)(lds + RG_WL + (ch0 + nt * 16 + fr) * 272 + (32 * kk + 8 * fq) * 2);
                    const bf16x8 bi = *(const LAS bf16x8*)(lds + RG_WL + 34816 + (ch0 + nt * 16 + fr) * 272 + (32 * kk + 8 * fq) * 2);
                    ar = __builtin_amdgcn_mfma_f32_16x16x32_bf16(a[kk], br, ar, 0, 0, 0); ai = __builtin_amdgcn_mfma_f32_16x16x32_bf16(a[kk], bi, ai, 0, 0, 0); }
                asm volatile("s_nop 15" : "+v"(ar), "+v"(ai));
                const int c = ch0 + nt * 16 + fr;
#pragma unroll
                for (int r = 0; r < 4; ++r) { const int row = mt + fq * 4 + r;
                    const float rr = sigm(ar[r] + brr[nt]), gi = sigm(ai[r] + bii[nt]);
                    const float la = sp8[nt] * rr, av = __expf(la), x2 = 2.f * la;
                    const float ser = -x2 * (1.f + x2 * (0.5f + x2 * (0.16666667f + x2 * (0.041666668f + x2 * 0.0083333338f))));
                    const float m2v = x2 > -0.25f ? ser : 1.f - av * av;
                    const float cv = bf1(*(const LAS bf16_t*)(At + row * 272 + c * 2));
                    abuf[row * 132 + c] = av; bbuf[row * 132 + c] = sqrtf(m2v) * gi * cv; }
            }
        }
        __syncthreads();
        if (prompt) {
            f32x2 hl[8], pl[8]; f32x2 hh = (f32x2){0.f, 0.f}, pp = (f32x2){1.f, 1.f};
#pragma unroll
            for (int i = 0; i < 8; ++i) { const int r = rg * 8 + i; const f32x2 av = *(const LAS f32x2*)(abuf + r * 132 + 2 * cp), bv = *(const LAS f32x2*)(bbuf + r * 132 + 2 * cp); hh = av * hh + bv; pp = pp * av; hl[i] = hh; pl[i] = pp; }
            LAS f32x4* comb = (LAS f32x4*)(lds + RG_AT);
            comb[rg * 64 + cp] = (f32x4){pp[0], hh[0], pp[1], hh[1]};
            __syncthreads();
            f32x2 Hp = (f32x2){0.f, 0.f}, Pp = (f32x2){1.f, 1.f};
            for (int s2 = 0; s2 < rg; ++s2) { const f32x4 c = comb[s2 * 64 + cp]; Hp = (f32x2){c[0], c[2]} * Hp + (f32x2){c[1], c[3]}; Pp = Pp * (f32x2){c[0], c[2]}; }
#pragma unroll
            for (int i = 0; i < 8; ++i) { const size_t o = (size_t)(row0 + rg * 8 + i) * D + chg2;
                const f32x2 hv = hl[i] + pl[i] * Hp, pv = pl[i] * Pp;
                *(unsigned*)(YB + o) = pk2(hv[0], hv[1]); *(unsigned*)(PBUF + o) = pk2(pv[0], pv[1]);
                if (rg == 7 && i == 7) *(f32x4*)(p.ws + WS_RGEND + ((size_t)tI * D + chg2) * 8) = (f32x4){pv[0], hv[0], pv[1], hv[1]}; }
        } else {
#pragma unroll
            for (int s2 = 0; s2 < 2; ++s2) { const int bs = (tI - 128) * 16 + rg * 2 + s2;
                f32x2 hh = *(const f32x2*)(p.in[I_RGH] + ((size_t)l * 128 + bs) * D + chg2);
#pragma unroll
                for (int tt = 0; tt < 4; ++tt) { const int r = rg * 8 + s2 * 4 + tt; hh = *(const LAS f32x2*)(abuf + r * 132 + 2 * cp) * hh + *(const LAS f32x2*)(bbuf + r * 132 + 2 * cp);
                    const unsigned z = *(const unsigned*)(PROJ + (size_t)(row0 + r) * INC + 4096 + chg2);
                    *(unsigned*)(YB + (size_t)(row0 + r) * D + chg2) = pk2(hh[0] * bflo(z), hh[1] * bfhi(z)); }
                *(f32x2*)(p.out + O_RGHS + ((size_t)l * 128 + bs) * D + chg2) = hh; }
        }
        __syncthreads();
    }
#undef RG_PREFETCH
}
__device__ __forceinline__ void phase_rg_fix(KP& p, int l) {
    const int lane = TID() & 63, wv = __builtin_amdgcn_readfirstlane(TID() >> 6);
    const bf16_t* PROJ = (const bf16_t*)(p.ws + WS_PROJ); bf16_t* YB = (bf16_t*)(p.ws + WS_YB); const bf16_t* PBUF = (const bf16_t*)(p.ws + WS_PB);
    for (int it = BID() * 8 + wv; it < 2048; it += GDIM() * 8) {
        const int tI = it >> 4, chg = (it & 15) * 128 + lane * 2, b = tI >> 5, k = tI & 31;
        float H0 = 0.f, H1 = 0.f;
        for (int jb = 0; jb < k; jb += 8) { f32x4 e[8];
#pragma unroll
            for (int u = 0; u < 8; ++u) { const int j = (jb + u) < 31 ? (jb + u) : 31; e[u] = *(const f32x4*)(p.ws + WS_RGEND + ((size_t)(b * 32 + j) * D + chg) * 8); }
#pragma unroll
            for (int u = 0; u < 8; ++u) { const bool on = (jb + u) < k; H0 = on ? e[u][0] * H0 + e[u][1] : H0; H1 = on ? e[u][2] * H1 + e[u][3] : H1; } }
        float h0 = 0.f, h1 = 0.f;
#pragma unroll 16
        for (int t = 0; t < 64; ++t) { const size_t o = (size_t)(tI * 64 + t) * D + chg;
            const unsigned hv = *(const unsigned*)(YB + o), pv = *(const unsigned*)(PBUF + o), zv = *(const unsigned*)(PROJ + (size_t)(tI * 64 + t) * INC + 4096 + chg);
            h0 = bflo(hv) + bflo(pv) * H0; h1 = bfhi(hv) + bfhi(pv) * H1;
            *(unsigned*)(YB + o) = pk2(h0 * bflo(zv), h1 * bfhi(zv)); }
        if (k == 31) *(f32x2*)(p.out + O_RGHP + ((size_t)l * 4 + b) * D + chg) = (f32x2){h0, h1};
    }
}


#define XB_TMO      128
#define XB_XCNT(j)  (256  + 64 * (j))
#define XB_XSUB(j)  (1280 + 64 * (j))
#define XB_XGEN(j)  (2304 + 64 * (j))
#define XB_TOP      3328
#define XB_TOPGEN   3392
#define XCD_BAR_WORDS 3456
#define XB_SPIN_CAP (1u << 23)
__device__ __forceinline__ unsigned xb_ld(unsigned* p)              { return __hip_atomic_load(p, __ATOMIC_RELAXED, __HIP_MEMORY_SCOPE_AGENT); }
__device__ __forceinline__ unsigned xb_add(unsigned* p, unsigned v) { return __hip_atomic_fetch_add(p, v, __ATOMIC_RELAXED, __HIP_MEMORY_SCOPE_AGENT); }
__device__ __forceinline__ unsigned xb_xcc_id() { return (unsigned)__builtin_amdgcn_s_getreg((3 << 11) | 20) & 0xFu; }
#define XB_SPIN(cond, bar) do { unsigned _sp = 0; while (cond) { __builtin_amdgcn_s_sleep(1); \
    if ((++_sp & 255u) == 0u) { if (xb_ld(&(bar)[XB_TMO])) break; if (_sp > XB_SPIN_CAP) { atomicAdd(&(bar)[XB_TMO], 1u); break; } } } } while (0)
__device__ __forceinline__ void xcd_barrier_complete(unsigned* bar, unsigned x, unsigned& nloc, unsigned& nx) {
    const unsigned G = gridDim.x;
    unsigned sum, cnt, mine, sp = 0u;
    for (;;) {
        sum = 0u; cnt = 0u; mine = 0u;
#pragma unroll
        for (unsigned j = 0; j < 16; ++j) { const unsigned c = xb_ld(&bar[XB_XCNT(j)]); sum += c; cnt += (c > 0u) ? 1u : 0u; mine = (j == x) ? c : mine; }
        if (sum == G) break;
        __builtin_amdgcn_s_sleep(1);
        if ((++sp & 255u) == 0u) { if (xb_ld(&bar[XB_TMO])) break; if (sp > XB_SPIN_CAP) { atomicAdd(&bar[XB_TMO], 1u); break; } }
    }
    nloc = mine > 0u ? mine : 1u; nx = cnt > 0u ? cnt : 1u;
}
__device__ __forceinline__ void xcd_barrier(unsigned* bar, volatile LAS unsigned* st) {
    asm volatile("s_waitcnt vmcnt(0)" ::: "memory");
    __syncthreads();
    if (threadIdx.x == 0) {
        const unsigned x = xb_xcc_id();
        __builtin_amdgcn_s_waitcnt(0);
        unsigned nloc = st[0], nx = st[1];
        if (nloc == 0u) { xcd_barrier_complete(bar, x, nloc, nx); st[0] = nloc; st[1] = nx; }
        const unsigned old = xb_add(&bar[XB_XSUB(x)], 1u);
        const unsigned gen = old / nloc;
        if (old + 1u == (gen + 1u) * nloc) {
            __builtin_amdgcn_fence(__ATOMIC_RELEASE, "agent");
            asm volatile("s_waitcnt vmcnt(0)" ::: "memory");
            const unsigned og = xb_add(&bar[XB_TOP], 1u);
            const unsigned tg = og / nx;
            if (og + 1u == (tg + 1u) * nx) xb_add(&bar[XB_TOPGEN], 1u);
            else XB_SPIN(xb_ld(&bar[XB_TOPGEN]) == tg, bar);
            __builtin_amdgcn_fence(__ATOMIC_ACQUIRE, "agent");
            xb_add(&bar[XB_XGEN(x)], 1u);
            asm volatile("s_waitcnt vmcnt(0)" ::: "memory");
        } else {
            XB_SPIN(xb_ld(&bar[XB_XGEN(x)]) == gen, bar);
            __builtin_amdgcn_fence(__ATOMIC_ACQUIRE, "agent");
            asm volatile("s_waitcnt vmcnt(0)" ::: "memory");
        }
    }
    __syncthreads();
}

#ifndef PH_MASK
#define PH_MASK 0x7ff
#endif
#define PH_ON(b) ((PH_MASK >> (b)) & 1)
#ifndef REP_MASK
#define REP_MASK 0
#endif
#define PH_REP(b) for (int rep_ = 0; rep_ < 1 + ((REP_MASK >> (b)) & 1); ++rep_)
__device__ __forceinline__ void run_phase(KP& p, int ph, LAS unsigned char* lds) {
    float* slab = (float*)(p.ws + WS_SLAB); unsigned* cnt = (unsigned*)(p.ws + WS_CNT) + ph * 128;
    if (ph == 0) { if (PH_ON(0)) PH_REP(0) { phase_prologue(p, lds); __syncthreads(); } return; }
    if (ph == 1) { if (PH_ON(1)) PH_REP(1) { EpiAda e; e.C = (float*)(p.ws + WS_ADA); e.bias = p.in[I_BADA];
        pg8::gemm_phase(lds, (const bf16_t*)(p.ws + WS_CB), (const bf16_t*)(p.ws + WS_WT_ADA), 256, 24576, 2048, e, slab, cnt);
        if (GDIM() == 256 && BID() >= 192) transpose_set(p, lds, 0, (BID() - 192) * 8 + (TID() >> 6), 64 * 8, 5120, TI_LAYER - 5120); } return; }
    if (ph == N_PHASES - 1) { if (PH_ON(2) && GDIM() != 256) phase_norm(p, 0, true); return; }
    const int l = (ph - 2) / 7, s = (ph - 2) % 7;
    switch (s) {
    case 0: if (PH_ON(2) && (l == 0 || GDIM() != 256)) PH_REP(2) phase_norm(p, l, false); break;
    case 1: if (PH_ON(3)) PH_REP(3) { EpiProj e; e.O = (bf16_t*)(p.ws + WS_PROJ); e.bias = p.in[I_BIN] + (size_t)l * INC;
        const int G = GDIM(), bid = BID(); const int Gg = (l + 1 < DEPTH && G == 256) ? 227 : G;
        if (bid < Gg) pg8::gemm_phase(lds, (const bf16_t*)(p.ws + WS_XN), (const bf16_t*)(p.ws + WS_WT_IN) + (size_t)l * INC * D, MR, INC, D, e, slab, cnt, Gg, bid);
        else transpose_set(p, lds, l + 1, (bid - Gg) * 8 + (TID() >> 6), (G - Gg) * 8);
        if (l + 1 < DEPTH && Gg == G) transpose_set(p, lds, l + 1, bid * 8 + (TID() >> 6), G * 8); } break;
    case 2: if (PH_ON(4)) PH_REP(4) { phase_s5<false>(p, l, lds); __syncthreads(); } if (PH_ON(9)) PH_REP(9) { phase_rg_local(p, l, lds); __syncthreads(); } break;
    case 3: { const int odd = __builtin_amdgcn_readfirstlane(TID() >> 6) & 1;
        for (int step = 0; step < 2; ++step) { if ((step ^ odd) == 0) { if (PH_ON(5)) phase_s5<true>(p, l, lds); } else { if (PH_ON(10)) phase_rg_fix(p, l); } }
        __syncthreads(); } break;
    case 4: if (PH_ON(6)) PH_REP(6) {
        const int G = GDIM(), bid = BID(); const int off = (G >= 136 + 16) ? G - 136 : 0; const bool chain = (G == 256);
        unsigned* cg2 = cnt + 102;
        if (bid >= off) { EpiGlu e; e.O = (bf16_t*)(p.ws + WS_YA); e.Y = (const bf16_t*)(p.ws + WS_YS5); e.PROJ = (const bf16_t*)(p.ws + WS_PROJ); e.bias = p.in[I_BGLU] + (size_t)l * S5W;
            pg8::gemm_phase(lds, (const bf16_t*)(p.ws + WS_YS5), (const bf16_t*)(p.ws + WS_WT_GLU) + (size_t)l * 1024 * 1024, MR, 1024, 1024, e, slab, cnt, G - off, bid - off);
            if (chain && TID() == 0) (void)__hip_atomic_fetch_add(cg2, 1u, __ATOMIC_RELAXED, __HIP_MEMORY_SCOPE_AGENT); }
        EpiPa eb; eb.T = (bf16_t*)(p.ws + WS_MTMP); eb.PROJ = (const bf16_t*)(p.ws + WS_PROJ); eb.goff = 8192;
        pg8::gemm_phase(lds, (const bf16_t*)(p.ws + WS_YB), (const bf16_t*)(p.ws + WS_WT_PB) + (size_t)l * 2048 * 2048, MR, 2048, 2048, eb, slab, cnt);
        if (chain) {
            asm volatile("s_waitcnt vmcnt(0)" ::: "memory");
            if (TID() == 0) { unsigned sp = 0; while (__hip_atomic_load(cg2, __ATOMIC_RELAXED, __HIP_MEMORY_SCOPE_AGENT) < 136u && ++sp < (1u << 24)) __builtin_amdgcn_s_sleep(1);
                __builtin_amdgcn_fence(__ATOMIC_ACQUIRE, "agent"); asm volatile("s_waitcnt vmcnt(0)" ::: "memory"); }
            __syncthreads();
            EpiPb ea; ea.O = (bf16_t*)(p.ws + WS_MERGED); ea.T = (const bf16_t*)(p.ws + WS_MTMP); ea.PROJ = (const bf16_t*)(p.ws + WS_PROJ); ea.goff = 6144;
            pg8::gemm_phase(lds, (const bf16_t*)(p.ws + WS_YA), (const bf16_t*)(p.ws + WS_WT_PA) + (size_t)l * 2048 * 1024, MR, 2048, 1024, ea, slab + (size_t)64 * 65536, cnt + 32); } } break;
    case 5: if (PH_ON(7) && GDIM() != 256) PH_REP(7) { EpiPb ea; ea.O = (bf16_t*)(p.ws + WS_MERGED); ea.T = (const bf16_t*)(p.ws + WS_MTMP); ea.PROJ = (const bf16_t*)(p.ws + WS_PROJ); ea.goff = 6144;
        pg8::gemm_phase(lds, (const bf16_t*)(p.ws + WS_YA), (const bf16_t*)(p.ws + WS_WT_PA) + (size_t)l * 2048 * 1024, MR, 2048, 1024, ea, slab, cnt); } break;
    case 6: if (PH_ON(8)) { EpiOut e; e.X = (bf16_t*)(p.ws + WS_X); e.xp = p.in[I_XP]; e.xs = p.in[I_XS]; e.ada_gate = (const float*)(p.ws + WS_ADA) + l * 6144 + 4096; e.first = (l == 0);
        const int hidden = (GDIM() == 256); e.hidden = hidden; e.cfull = cnt + 100; e.cpiece = cnt + 101;
        pg8::gemm_phase(lds, (const bf16_t*)(p.ws + WS_MERGED), (const bf16_t*)(p.ws + WS_WT_OUT) + (size_t)l * 2048 * 2048, MR, 2048, 2048, e, slab, cnt);
        if (hidden && BID() >= 64) {
            const int w = (BID() - 64) * 8 + (TID() >> 6), nw = 192 * 8; const bool fin = (l + 1 == DEPTH);
            if (TID() == 0) { unsigned sp = 0; while (__hip_atomic_load(e.cfull, __ATOMIC_RELAXED, __HIP_MEMORY_SCOPE_AGENT) < 256u && ++sp < (1u << 24)) __builtin_amdgcn_s_sleep(1);
                __builtin_amdgcn_fence(__ATOMIC_ACQUIRE, "agent"); asm volatile("s_waitcnt vmcnt(0)" ::: "memory"); }
            __syncthreads();
            phase_norm(p, l + 1, fin, w, nw, 0, NP);
            if (TID() == 0) { unsigned sp = 0; while (__hip_atomic_load(e.cpiece, __ATOMIC_RELAXED, __HIP_MEMORY_SCOPE_AGENT) < 64u && ++sp < (1u << 24)) __builtin_amdgcn_s_sleep(1);
                __builtin_amdgcn_fence(__ATOMIC_ACQUIRE, "agent"); asm volatile("s_waitcnt vmcnt(0)" ::: "memory"); }
            __syncthreads();
            phase_norm(p, l + 1, fin, w, nw, NP, MR);
        } } break;
    }
}

__global__ void __launch_bounds__(512, 2) mega(Params p) {
    extern __shared__ __attribute__((aligned(16))) unsigned char smem[];
    LAS unsigned char* lds = (LAS unsigned char*)smem;
    volatile LAS unsigned* st = (volatile LAS unsigned*)(lds + LDS_PHASE);
    unsigned* bar = (unsigned*)(p.ws + WS_BAR);
    if (p.ph_hi - p.ph_lo > 1) {
        if (threadIdx.x == 0) { st[0] = 0u; st[1] = 0u; (void)xb_add(&bar[XB_XCNT(xb_xcc_id())], 1u); }
        __syncthreads();
    }
    if (p.ph_lo < 0) cg::this_grid().sync();
    for (int ph = p.ph_lo; ph < p.ph_hi; ++ph) {
        if (gridDim.x == 256 && p.ph_hi - p.ph_lo > 1 && (ph == N_PHASES - 1 || (ph >= 9 && (ph - 2) % 7 == 0) || (ph >= 2 && (ph - 2) % 7 == 5))) continue;
        if (ph > p.ph_lo) {
            xcd_barrier(bar, st);
#ifdef EXTRA_SYNC
            xcd_barrier(bar, st);
#endif
        }
        KP* pp = (KP*)__builtin_amdgcn_kernarg_segment_ptr();
        asm volatile("" : "+s"(pp));
        run_phase(*pp, ph, lds);
    }
}

extern "C" void kernel_launch(void* const* d_in, const int* in_sizes, int n_in, void* d_out, int out_size, void* d_ws, size_t ws_size, hipStream_t stream) {
    static int grid = 0;
    if (grid == 0) {
        if (n_in != N_IN || (size_t)out_size != O_END || ws_size < WS_END) { fprintf(stderr, "kernel_launch: unexpected shapes n_in %d out %d ws %zu (need %zu)\n", n_in, out_size, ws_size, (size_t)WS_END); grid = -1; return; }
        int dev = 0, cus = 0, per_cu = 0;
        hipGetDevice(&dev); hipDeviceGetAttribute(&cus, hipDeviceAttributeMultiprocessorCount, dev);
        if (hipFuncSetAttribute((const void*)mega, hipFuncAttributeMaxDynamicSharedMemorySize, LDS_BYTES) != hipSuccess) { fprintf(stderr, "kernel_launch: hipFuncSetAttribute failed\n"); grid = -1; return; }
        hipOccupancyMaxActiveBlocksPerMultiprocessor(&per_cu, (const void*)mega, 512, LDS_BYTES);
        (void)hipGetLastError();
        if (per_cu < 1) { fprintf(stderr, "kernel_launch: occupancy query says %d blocks/CU\n", per_cu); per_cu = 1; }
        grid = cus;
        if (grid % 16) grid -= grid % 16;
    }
    if (grid < 0) return;
    if (hipMemsetAsync((char*)d_ws + WS_BAR, 0, 32768, stream) != hipSuccess) { fprintf(stderr, "kernel_launch: memset failed\n"); return; }
    Params p{};
    for (int i = 0; i < N_IN; ++i) p.in[i] = (const float*)d_in[i];
    p.out = (float*)d_out; p.ws = (unsigned char*)d_ws;
#if MK_MULTI
    for (int ph = 0; ph < N_PHASES; ++ph) { p.ph_lo = ph; p.ph_hi = ph + 1; hipLaunchKernelGGL(mega, dim3(grid), dim3(512), LDS_BYTES, stream, p); }
#else
    p.ph_lo = 0; p.ph_hi = N_PHASES;
    void* args[] = {&p};
    hipError_t e = hipLaunchCooperativeKernel((const void*)mega, dim3(grid), dim3(512), args, LDS_BYTES, stream);
    if (e != hipSuccess) fprintf(stderr, "kernel_launch: cooperative launch failed: %s (grid %d)\n", hipGetErrorString(e), grid);
#endif
}
```

```cpp
#include <hip/hip_runtime.h>
#include <hip/hip_cooperative_groups.h>
#include <cstdio>
#include <cstdint>
namespace cg = cooperative_groups;

#ifndef MK_MULTI
#define MK_MULTI 0
#endif

#define LAS __attribute__((address_space(3)))
typedef unsigned short bf16_t;
typedef short bf16x8 __attribute__((ext_vector_type(8)));
typedef float f32x4 __attribute__((ext_vector_type(4)));
typedef float f32x2 __attribute__((ext_vector_type(2)));
typedef unsigned u32x4 __attribute__((ext_vector_type(4)));
typedef unsigned u32x2 __attribute__((ext_vector_type(2)));
typedef f32x4 QuarT[4][2];

constexpr int D = 2048, NP = 8192, NSR = 512, MR = 8704, DEPTH = 4, INC = 10240, S5W = 1024;
constexpr int NTILE = 136;
constexpr float EPS = 1e-6f;
enum { I_XP = 0, I_XS, I_S5RE, I_S5IM, I_RGH, I_CONV, I_CP, I_CS, I_WADA, I_BADA, I_NG, I_WIN, I_BIN, I_LAMRE, I_LAMIM, I_LOGDT,
       I_BRE, I_BIM, I_CRE, I_CIM, I_S5D, I_WGLU, I_BGLU, I_CW, I_CBIAS, I_WR, I_BR, I_WI, I_BI, I_LAM, I_WPA, I_WPB, I_WOUT, I_FG, N_IN };
constexpr size_t O_YP = 0, O_YS = O_YP + (size_t)NP * D, O_S5RP = O_YS + (size_t)NSR * D, O_S5IP = O_S5RP + 4 * 4 * 4096,
                 O_RGHP = O_S5IP + 4 * 4 * 4096, O_CONVP = O_RGHP + 4 * 4 * 2048, O_S5RS = O_CONVP + 4 * 4 * 3 * 2048,
                 O_S5IS = O_S5RS + (size_t)4 * 128 * 4096, O_RGHS = O_S5IS + (size_t)4 * 128 * 4096, O_CONVS = O_RGHS + (size_t)4 * 128 * 2048,
                 O_END = O_CONVS + (size_t)4 * 128 * 3 * 2048;
constexpr size_t WS_WT_IN = 0, WS_WT_ADA = WS_WT_IN + (size_t)4 * INC * D * 2, WS_WT_GLU = WS_WT_ADA + (size_t)4 * 6144 * D * 2,
                 WS_WT_PA = WS_WT_GLU + (size_t)4 * 1024 * 1024 * 2, WS_WT_PB = WS_WT_PA + (size_t)4 * 2048 * 1024 * 2,
                 WS_WT_OUT = WS_WT_PB + (size_t)4 * 2048 * 2048 * 2, WS_WT_RG = WS_WT_OUT + (size_t)4 * 2048 * 2048 * 2,
                 WS_CB = WS_WT_RG + (size_t)4 * 2 * 16 * 16384 * 2, WS_ADA = WS_CB + (size_t)256 * D * 2, WS_X = WS_ADA + (size_t)256 * 24576 * 4,
                 WS_XN = WS_X + (size_t)MR * D * 4, WS_PROJ = WS_XN + (size_t)MR * D * 2, WS_YS5 = WS_PROJ + (size_t)MR * INC * 2,
                 WS_YA = WS_YS5 + (size_t)MR * S5W * 2, WS_YB = WS_YA + (size_t)MR * S5W * 2, WS_PB = WS_YB + (size_t)MR * D * 2,
                 WS_MTMP = WS_PB + (size_t)NP * D * 2, WS_MERGED = WS_MTMP + (size_t)MR * D * 4, WS_S5ABAR = WS_MERGED + (size_t)MR * D * 2,
                 WS_S5BBR = WS_S5ABAR + (size_t)4 * 4096 * 16, WS_S5BBI = WS_S5BBR + (size_t)4 * 4096 * 64, WS_S5LOCR = WS_S5BBI + (size_t)4 * 4096 * 64,
                 WS_S5LOCI = WS_S5LOCR + (size_t)4 * 32 * 4096 * 4, WS_RGEND = WS_S5LOCI + (size_t)4 * 32 * 4096 * 4,
                 WS_BAR = WS_RGEND + (size_t)4 * 32 * 2048 * 8, WS_CNT = WS_BAR + 16384, WS_SLAB = WS_CNT + 16384, WS_END = WS_SLAB + (size_t)240 * 262144;
constexpr int LDS_PHASE = 158720, LDS_BYTES = LDS_PHASE + 16;
constexpr int N_PHASES = 2 + 7 * DEPTH + 1;

struct Params { const float* in[N_IN]; float* out; unsigned char* ws; int ph_lo, ph_hi; };

#define KP const __attribute__((address_space(4))) Params
__device__ __forceinline__ int TID() { int t = threadIdx.x; asm volatile("" : "+v"(t)); return t; }
__device__ __forceinline__ int BID() { int t = blockIdx.x; asm volatile("" : "+s"(t)); return t; }
__device__ __forceinline__ int GDIM() { int t = gridDim.x; asm volatile("" : "+s"(t)); return t; }
#define LDS_WAIT() asm volatile("s_waitcnt lgkmcnt(0)" ::: "memory")
__device__ __forceinline__ unsigned pk2(float lo, float hi) { unsigned r; asm("v_cvt_pk_bf16_f32 %0, %1, %2" : "=v"(r) : "v"(lo), "v"(hi)); return r; }
__device__ __forceinline__ float bflo(unsigned w) { return __uint_as_float(w << 16); }
__device__ __forceinline__ float bfhi(unsigned w) { return __uint_as_float(w & 0xffff0000u); }
__device__ __forceinline__ float bf1(bf16_t b) { return __uint_as_float(((unsigned)b) << 16); }
__device__ __forceinline__ float sigm(float x) { return __builtin_amdgcn_rcpf(1.f + __expf(-x)); }
__device__ __forceinline__ float wave_sum(float v) {
#pragma unroll
    for (int o = 1; o < 64; o <<= 1) v += __shfl_xor(v, o);
    return v;
}
__device__ __forceinline__ int row_b(int row) { return row < NP ? (row >> 11) : 4 + ((row - NP) >> 2); }
__device__ __forceinline__ const float* xrow_ptr(KP& p, int l, int row) {
    if (l == 0) return row < NP ? p.in[I_XP] + (size_t)row * D : p.in[I_XS] + (size_t)(row - NP) * D;
    return (const float*)(p.ws + WS_X) + (size_t)row * D;
}

namespace pg8 {
constexpr int BM = 256, BK = 64, HALF = 128, HTB = HALF * BK * 2, STAGE_BYTES = 8 * HTB, NXCD = 8, WGM = 8;
__device__ __forceinline__ int lds_byte(int r, int c) { const int st = (r >> 4) * 2 + (c >> 5), rr = r & 15, cc = c & 31, ob = rr * 64 + cc * 2; return st * 1024 + (ob ^ (((ob >> 9) & 1) << 5)); }
__device__ __forceinline__ void stage_rc(int b, int& R, int& C) { const int st = b / 1024, sb = b % 1024, swz = sb ^ (((sb >> 9) & 1) << 5); R = (st >> 1) * 16 + swz / 64; C = (st & 1) * 32 + (swz % 64) / 2; }
__device__ __forceinline__ int perm32(int rho) { const int n = rho >> 4, i = rho & 15; return 8 * (i >> 2) + 4 * n + (i & 3); }
struct Unit { int pm, pn, kt0, nt; };
struct StaticOrder {
    int nM, nN, nwg, G, c, R, ntail, S, ntK, sl;
    __device__ __forceinline__ void init(int M, int N, int K, int G_, int c_, bool split, int sl_ = 0) { sl = sl_; nM = M / BM; nN = N / BM; nwg = nM * nN; G = G_; c = c_; R = nwg / G; ntail = nwg - R * G; ntK = K / BK;
        S = 1; if (split && ntail > 0) { if (ntail * 4 <= G && ntK >= 16) S = 4; else if (ntail * 3 <= G && ntK == 32) S = 3; else if (ntail * 2 <= G && ntK >= 8) S = 2; } }
    __device__ __forceinline__ void map(int L, Unit& u) const {
        if (sl) { if (L < 256) { u.pm = (L & 7) * 4 + ((L >> 3) & 3); u.pn = L >> 5; } else { u.pm = 32 + ((L - 256) >> 3); u.pn = (L - 256) & 7; } return; }
        int wgid = L; { const int q = nwg / NXCD, r = nwg % NXCD, xcd = wgid % NXCD, off = wgid / NXCD; wgid = (xcd < r ? xcd * (q + 1) : r * (q + 1) + (xcd - r) * q) + off; }
        const int nig = WGM * nN, gid = wgid / nig, fm = gid * WGM, gsz = (nM - fm) < WGM ? (nM - fm) : WGM;
        u.pm = fm + ((wgid % nig) % gsz); u.pn = (wgid % nig) / gsz; }
    __device__ __forceinline__ bool piece(int i, int& tu, int& sl) const { if (i != R || S == 1) return false; const int x = c & 7, y = c >> 3; sl = y % S; tu = (y / S) * 8 + x; return tu < ntail; }
    __device__ __forceinline__ bool next(int i, Unit& u) const {
        u.kt0 = 0; u.nt = ntK;
        if (i < R) { map(i * G + c, u); return true; }
        if (i > R || ntail == 0) return false;
        if (S == 1) { if (c >= ntail) return false; map(R * G + c, u); return true; }
        int tu, s_; if (!piece(i, tu, s_)) return false;
        map(R * G + tu, u);
        if (S == 3) { u.nt = s_ < 2 ? 10 : 12; u.kt0 = s_ * 10; } else { u.nt = ntK / S; u.kt0 = s_ * u.nt; }
        return true;
    }
};
template <class Epi>
__device__ __forceinline__ void gemm_phase(LAS unsigned char* lds, const bf16_t* gA, const bf16_t* gBt, int M, int N, int K, const Epi& E, float* slab, unsigned* cnt, int G_ = 0, int c_ = 0) {
    const int tid = TID(), wid = __builtin_amdgcn_readfirstlane(tid >> 6), lane = tid & 63, wr = wid >> 2, wc = wid & 3, fr = lane & 15, fq = lane >> 4;
    int sl_ = 0; if constexpr (Epi::PUBLISH) sl_ = E.hidden;
    StaticOrder S; if (G_ > 0) S.init(M, N, K, G_, c_, cnt != nullptr, sl_); else S.init(M, N, K, GDIM(), BID(), cnt != nullptr, sl_);
    unsigned voffA[2], voffB[2];
#pragma unroll
    for (int i = 0; i < 2; ++i) { int R, C; stage_rc(tid * 16 + i * 8192, R, C); const int Rb = Epi::PERM ? ((R & ~31) + perm32(R & 31)) : R;
        voffA[i] = (unsigned)(R * K + C) * 2u; voffB[i] = (unsigned)(Rb * K + C) * 2u; }
    const size_t kstep = (size_t)(BK * 2);
    const size_t hstep = (size_t)HALF * K * 2;
    const size_t tstep = 2 * hstep;
    const unsigned ldsw = (unsigned)wid * 1024u;
    const int aoff = lds_byte(wr * 64 + fr, fq * 8), boff = lds_byte(wc * 32 + fr, fq * 8);
#define PG8_SA(b, h) (((b) * 2 + (h)) * HTB)
#define PG8_SB(b, h) ((4 + (b) * 2 + (h)) * HTB)
#define PG8_STAGE(bufoff, gbase, voff) do { _Pragma("unroll") for (int _i = 0; _i < 2; ++_i) \
        __builtin_amdgcn_global_load_lds((const unsigned*)((const char*)(gbase) + (voff)[_i]), (LAS unsigned*)(lds + (bufoff) + ldsw + _i * 8192), 16, 0, 0); } while (0)
#define PG8_LDA(dst, b, h) do { _Pragma("unroll") for (int m = 0; m < 4; ++m) _Pragma("unroll") for (int k = 0; k < 2; ++k) dst[m][k] = *(const LAS bf16x8*)(lds + PG8_SA(b, h) + aoff + m * 2048 + k * 1024); } while (0)
#define PG8_LDB(dst, b, h) do { _Pragma("unroll") for (int n = 0; n < 2; ++n) _Pragma("unroll") for (int k = 0; k < 2; ++k) dst[n][k] = *(const LAS bf16x8*)(lds + PG8_SB(b, h) + boff + n * 2048 + k * 1024); } while (0)
#define PG8_MMA(ai, bj, At, Bt) do { __builtin_amdgcn_s_setprio(1); _Pragma("unroll") for (int m = 0; m < 4; ++m) _Pragma("unroll") for (int n = 0; n < 2; ++n) _Pragma("unroll") for (int k = 0; k < 2; ++k) \
        acc[ai][bj][m][n] = __builtin_amdgcn_mfma_f32_16x16x32_bf16(Bt[n][k], At[m][k], acc[ai][bj][m][n], 0, 0, 0); __builtin_amdgcn_s_setprio(0); } while (0)
#define PG8_WAIT_V(n) asm volatile("s_waitcnt vmcnt(" #n ")" ::: "memory")
#define PG8_WAIT_L(n) asm volatile("s_waitcnt lgkmcnt(" #n ")" ::: "memory")
#define PG8_BAR __builtin_amdgcn_s_barrier()
#define PG8_SCHED __builtin_amdgcn_sched_barrier(0)
    Unit cur, nxt; int ui = 0;
    if (!S.next(0, cur)) return;
    f32x4 acc[2][2][4][2];
#pragma unroll
    for (int a = 0; a < 2; ++a)
#pragma unroll
        for (int b = 0; b < 2; ++b)
#pragma unroll
            for (int m = 0; m < 4; ++m)
#pragma unroll
                for (int n = 0; n < 2; ++n) acc[a][b][m][n] = (f32x4){0.f, 0.f, 0.f, 0.f};
    bf16x8 At[4][2], B0[2][2], B1[2][2];
    const char* cA = (const char*)gA + (size_t)cur.pm * tstep + (size_t)cur.kt0 * kstep; const char* cB = (const char*)gBt + (size_t)cur.pn * tstep + (size_t)cur.kt0 * kstep;
    PG8_STAGE(PG8_SB(0, 0), cB, voffB); PG8_STAGE(PG8_SB(0, 1), cB + hstep, voffB); PG8_STAGE(PG8_SA(0, 0), cA, voffA); PG8_STAGE(PG8_SA(0, 1), cA + hstep, voffA);
    if (wr == 1) PG8_BAR;
    PG8_WAIT_V(2); PG8_BAR;
    PG8_STAGE(PG8_SB(1, 0), cB + kstep, voffB); PG8_STAGE(PG8_SA(1, 0), cA + kstep, voffA); PG8_STAGE(PG8_SB(1, 1), cB + hstep + kstep, voffB);
    PG8_WAIT_V(6); PG8_BAR;
    for (;;) {
        const bool has_next = S.next(ui + 1, nxt);
        const char* nA = has_next ? (const char*)gA + (size_t)nxt.pm * tstep + (size_t)nxt.kt0 * kstep : cA; const char* nB = has_next ? (const char*)gBt + (size_t)nxt.pn * tstep + (size_t)nxt.kt0 * kstep : cB;
        const int nt = cur.nt;
        for (int t = 0; t < nt; t += 2) {
            const bool last = (t == nt - 2);
            const char* a1 = cA + (size_t)(t + 1) * kstep;
            const char* a2 = last ? nA : cA + (size_t)(t + 2) * kstep; const char* b2 = last ? nB : cB + (size_t)(t + 2) * kstep;
            const char* a3 = a2 + kstep; const char* b3 = b2 + kstep;
            PG8_LDB(B0, 0, 0); PG8_LDB(B1, 0, 1); PG8_SCHED; PG8_LDA(At, 0, 0); PG8_STAGE(PG8_SA(1, 1), a1 + hstep, voffA);
            PG8_WAIT_V(8); PG8_WAIT_L(0); PG8_BAR; PG8_MMA(0, 0, At, B0); PG8_MMA(0, 1, At, B1); PG8_BAR; PG8_SCHED;
            PG8_LDA(At, 0, 1); PG8_STAGE(PG8_SB(0, 0), b2, voffB); PG8_STAGE(PG8_SB(0, 1), b2 + hstep, voffB); PG8_STAGE(PG8_SA(0, 0), a2, voffA);
            PG8_WAIT_V(8); PG8_WAIT_L(0); PG8_BAR; PG8_MMA(1, 0, At, B0); PG8_MMA(1, 1, At, B1); PG8_BAR; PG8_SCHED;
            PG8_LDB(B0, 1, 0); PG8_LDB(B1, 1, 1); PG8_SCHED; PG8_LDA(At, 1, 0); PG8_STAGE(PG8_SA(0, 1), a2 + hstep, voffA);
            PG8_WAIT_V(8); PG8_WAIT_L(0); PG8_BAR; PG8_MMA(0, 0, At, B0); PG8_MMA(0, 1, At, B1); PG8_BAR; PG8_SCHED;
            PG8_LDA(At, 1, 1); PG8_STAGE(PG8_SB(1, 0), b3, voffB); PG8_STAGE(PG8_SB(1, 1), b3 + hstep, voffB); PG8_STAGE(PG8_SA(1, 0), a3, voffA);
            PG8_WAIT_V(8); PG8_WAIT_L(0); PG8_BAR; PG8_MMA(1, 0, At, B0); PG8_MMA(1, 1, At, B1); PG8_BAR; PG8_SCHED;
        }
        if (wr == 0) PG8_BAR;
        int ptu, psl; const bool is_piece = S.piece(ui, ptu, psl);
        if (!is_piece) E(acc, cur, wr, wc, fr, fq);
        else {
            float* sl = slab + (size_t)(ptu * S.S + psl) * 65536 + tid * 4;
#pragma unroll
            for (int a = 0; a < 2; ++a)
#pragma unroll
                for (int b = 0; b < 2; ++b)
#pragma unroll
                    for (int m = 0; m < 4; ++m)
#pragma unroll
                        for (int n = 0; n < 2; ++n) { float* sp_ = sl + (((a * 2 + b) * 4 + m) * 2 + n) * 2048;
                            asm volatile("global_store_dwordx4 %0, %1, off sc1\n\ts_nop 1" :: "v"(sp_), "v"(acc[a][b][m][n]) : "memory"); }
        }
        if constexpr (Epi::PUBLISH) { if (E.hidden && !is_piece) {
            asm volatile("s_waitcnt vmcnt(0)" ::: "memory"); __syncthreads();
            if (tid == 0) (void)__hip_atomic_fetch_add(E.cfull, 1u, __ATOMIC_RELAXED, __HIP_MEMORY_SCOPE_AGENT); } }
        if (!has_next) break;
#pragma unroll
        for (int a = 0; a < 2; ++a)
#pragma unroll
            for (int b = 0; b < 2; ++b)
#pragma unroll
                for (int m = 0; m < 4; ++m)
#pragma unroll
                    for (int n = 0; n < 2; ++n) acc[a][b][m][n] = (f32x4){0.f, 0.f, 0.f, 0.f};
        cur = nxt; cA = nA; cB = nB; ++ui;
        if (wr == 1) PG8_BAR;
    }
    PG8_WAIT_V(0);
    PG8_BAR;
    int ptu, psl;
    if (S.piece(ui, ptu, psl)) {
        const int nS = S.S;
        asm volatile("s_waitcnt vmcnt(0)" ::: "memory");
        __syncthreads();
        if (tid == 0) {
            (void)__hip_atomic_fetch_add(cnt + ptu, 1u, __ATOMIC_RELAXED, __HIP_MEMORY_SCOPE_AGENT);
            unsigned sp = 0;
            while (__hip_atomic_load(cnt + ptu, __ATOMIC_RELAXED, __HIP_MEMORY_SCOPE_AGENT) < (unsigned)nS && ++sp < (1u << 24)) __builtin_amdgcn_s_sleep(1);
            __builtin_amdgcn_fence(__ATOMIC_ACQUIRE, "agent");
            asm volatile("s_waitcnt vmcnt(0)" ::: "memory");
        }
        __syncthreads();
        const int q0 = (nS == 2) ? 2 * psl : psl, q1 = (nS == 2) ? 2 * psl + 1 : ((nS == 3 && psl == 0) ? 3 : -1);
        for (int qi = 0; qi < 2; ++qi) { const int qq = qi ? q1 : q0; if (qq < 0) break;
            QuarT q;
#pragma unroll
            for (int m = 0; m < 4; ++m)
#pragma unroll
                for (int n = 0; n < 2; ++n) q[m][n] = (f32x4){0.f, 0.f, 0.f, 0.f};
            for (int s2 = 0; s2 < nS; ++s2) { const float* sl = slab + (size_t)(ptu * nS + s2) * 65536 + (size_t)qq * 8 * 2048 + tid * 4;
#pragma unroll
                for (int m = 0; m < 4; ++m)
#pragma unroll
                    for (int n = 0; n < 2; ++n) q[m][n] += *(const f32x4*)(sl + (m * 2 + n) * 2048); }
            E.quarter(q, cur, qq >> 1, qq & 1, wr, wc, fr, fq);
        }
        if constexpr (Epi::PUBLISH) asm volatile("s_waitcnt vmcnt(0)" ::: "memory");
        __syncthreads();
        if constexpr (Epi::PUBLISH) { if (E.hidden && tid == 0) (void)__hip_atomic_fetch_add(E.cpiece, 1u, __ATOMIC_RELAXED, __HIP_MEMORY_SCOPE_AGENT); }
    }
#undef PG8_SA
#undef PG8_SB
#undef PG8_STAGE
#undef PG8_LDA
#undef PG8_LDB
#undef PG8_MMA
#undef PG8_WAIT_V
#undef PG8_WAIT_L
#undef PG8_BAR
#undef PG8_SCHED
}
}
using pg8::Unit;
typedef f32x4 AccT[2][2][4][2];

#define EPI_ALL_QUARTERS \
    __device__ __forceinline__ void operator()(const AccT& acc, const Unit& u, int wr, int wc, int fr, int fq) const { \
        _Pragma("unroll") for (int ai = 0; ai < 2; ++ai) _Pragma("unroll") for (int bj = 0; bj < 2; ++bj) { quarter(acc[ai][bj], u, ai, bj, wr, wc, fr, fq); __builtin_amdgcn_sched_barrier(0); } }
struct EpiAda {
    static constexpr bool PERM = false, PUBLISH = false;
    float* C; const float* bias;
    __device__ __forceinline__ void quarter(const QuarT& q, const Unit& u, int ai, int bj, int wr, int wc, int fr, int fq) const {
        const int row0 = u.pm * 256 + ai * 128 + wr * 64 + fr, col0 = u.pn * 256 + bj * 128 + wc * 32 + 4 * fq;
        const f32x4 b0 = *(const f32x4*)(bias + col0), b1 = *(const f32x4*)(bias + col0 + 16);
#pragma unroll
        for (int m = 0; m < 4; ++m) { float* rowp = C + (size_t)(row0 + m * 16) * 24576 + col0; *(f32x4*)rowp = q[m][0] + b0; *(f32x4*)(rowp + 16) = q[m][1] + b1; }
    }
    EPI_ALL_QUARTERS
};
struct EpiProj {
    static constexpr bool PERM = true, PUBLISH = false;
    bf16_t* O; const float* bias;
    __device__ __forceinline__ void quarter(const QuarT& q, const Unit& u, int ai, int bj, int wr, int wc, int fr, int fq) const {
        const int row0 = u.pm * 256 + ai * 128 + wr * 64 + fr, colt = u.pn * 256, col0 = colt + bj * 128 + wc * 32 + 8 * fq;
        const int mode = (colt >= 6144) ? 2 : (((colt >= 1024 && colt < 2048) || colt >= 4096) ? 1 : 0);
        const f32x4 b0 = *(const f32x4*)(bias + col0), b1 = *(const f32x4*)(bias + col0 + 4);
#pragma unroll
        for (int m = 0; m < 4; ++m) { f32x4 v0 = q[m][0] + b0, v1 = q[m][1] + b1;
            if (mode) {
#pragma unroll
                for (int e = 0; e < 4; ++e) { const float s0 = sigm(v0[e]), s1 = sigm(v1[e]); v0[e] = (mode == 2) ? s0 : v0[e] * s0; v1[e] = (mode == 2) ? s1 : v1[e] * s1; } }
            u32x4 o; o.x = pk2(v0[0], v0[1]); o.y = pk2(v0[2], v0[3]); o.z = pk2(v1[0], v1[1]); o.w = pk2(v1[2], v1[3]);
            *(u32x4*)(O + (size_t)(row0 + m * 16) * INC + col0) = o; }
    }
    EPI_ALL_QUARTERS
};
struct EpiGlu {
    static constexpr bool PERM = true, PUBLISH = false;
    bf16_t* O; const bf16_t* Y; const bf16_t* PROJ; const float* bias;
    __device__ __forceinline__ void quarter(const QuarT& q, const Unit& u, int ai, int bj, int wr, int wc, int fr, int fq) const {
        const int row0 = u.pm * 256 + ai * 128 + wr * 64 + fr, col = u.pn * 256 + bj * 128 + wc * 32 + 8 * fq;
        const f32x4 b0 = *(const f32x4*)(bias + col), b1 = *(const f32x4*)(bias + col + 4);
#pragma unroll
        for (int m = 0; m < 4; ++m) { const size_t row = (size_t)(row0 + m * 16);
            const u32x4 yv = *(const u32x4*)(Y + row * S5W + col), zv = *(const u32x4*)(PROJ + row * INC + 1024 + col);
            const f32x4 v0 = q[m][0] + b0, v1 = q[m][1] + b1;
            u32x4 o;
            o.x = pk2(bflo(yv.x) * sigm(v0[0]) * bflo(zv.x), bfhi(yv.x) * sigm(v0[1]) * bfhi(zv.x));
            o.y = pk2(bflo(yv.y) * sigm(v0[2]) * bflo(zv.y), bfhi(yv.y) * sigm(v0[3]) * bfhi(zv.y));
            o.z = pk2(bflo(yv.z) * sigm(v1[0]) * bflo(zv.z), bfhi(yv.z) * sigm(v1[1]) * bfhi(zv.z));
            o.w = pk2(bflo(yv.w) * sigm(v1[2]) * bflo(zv.w), bfhi(yv.w) * sigm(v1[3]) * bfhi(zv.w));
            { bf16_t* yo_ = O + row * S5W + col; asm volatile("global_store_dwordx4 %0, %1, off sc1\n\ts_nop 1" :: "v"(yo_), "v"(o) : "memory"); } }
    }
    EPI_ALL_QUARTERS
};
struct EpiPa {
    static constexpr bool PERM = true, PUBLISH = false;
    bf16_t* T; const bf16_t* PROJ; int goff;
    __device__ __forceinline__ void quarter(const QuarT& q, const Unit& u, int ai, int bj, int wr, int wc, int fr, int fq) const {
        const int row0 = u.pm * 256 + ai * 128 + wr * 64 + fr, col = u.pn * 256 + bj * 128 + wc * 32 + 8 * fq;
#pragma unroll
        for (int m = 0; m < 4; ++m) { const size_t row = (size_t)(row0 + m * 16);
            const u32x4 g = *(const u32x4*)(PROJ + row * INC + goff + col);
            const f32x4 a0 = q[m][0], a1 = q[m][1];
            u32x4 o; o.x = pk2(bflo(g.x) * a0[0], bfhi(g.x) * a0[1]); o.y = pk2(bflo(g.y) * a0[2], bfhi(g.y) * a0[3]);
            o.z = pk2(bflo(g.z) * a1[0], bfhi(g.z) * a1[1]); o.w = pk2(bflo(g.w) * a1[2], bfhi(g.w) * a1[3]);
            *(u32x4*)(T + row * D + col) = o; }
    }
    EPI_ALL_QUARTERS
};
struct EpiPb {
    static constexpr bool PERM = true, PUBLISH = false;
    bf16_t* O; const bf16_t* T; const bf16_t* PROJ; int goff;
    __device__ __forceinline__ void quarter(const QuarT& q, const Unit& u, int ai, int bj, int wr, int wc, int fr, int fq) const {
        const int row0 = u.pm * 256 + ai * 128 + wr * 64 + fr, col = u.pn * 256 + bj * 128 + wc * 32 + 8 * fq;
#pragma unroll
        for (int m = 0; m < 4; ++m) { const size_t row = (size_t)(row0 + m * 16);
            const u32x4 g = *(const u32x4*)(PROJ + row * INC + goff + col), t = *(const u32x4*)(T + row * D + col);
            const f32x4 a0 = q[m][0], a1 = q[m][1];
            u32x4 o;
            o.x = pk2(bflo(t.x) + bflo(g.x) * a0[0], bfhi(t.x) + bfhi(g.x) * a0[1]); o.y = pk2(bflo(t.y) + bflo(g.y) * a0[2], bfhi(t.y) + bfhi(g.y) * a0[3]);
            o.z = pk2(bflo(t.z) + bflo(g.z) * a1[0], bfhi(t.z) + bfhi(g.z) * a1[1]); o.w = pk2(bflo(t.w) + bflo(g.w) * a1[2], bfhi(t.w) + bfhi(g.w) * a1[3]);
            *(u32x4*)(O + row * D + col) = o; }
    }
    EPI_ALL_QUARTERS
};
struct EpiOut {
    static constexpr bool PERM = true, PUBLISH = true;
    bf16_t* X; const float* xp; const float* xs; const float* ada_gate; int first;
    int hidden; unsigned* cfull; unsigned* cpiece;
    __device__ __forceinline__ void quarter(const QuarT& q, const Unit& u, int ai, int bj, int wr, int wc, int fr, int fq) const {
        const int row0 = u.pm * 256 + ai * 128 + wr * 64 + fr, col = u.pn * 256 + bj * 128 + wc * 32 + 8 * fq;
#pragma unroll
        for (int m = 0; m < 4; ++m) { const int row = row0 + m * 16;
            f32x4 x0, x1;
            if (first) { const float* xin = row < NP ? xp + (size_t)row * D : xs + (size_t)(row - NP) * D; x0 = *(const f32x4*)(xin + col); x1 = *(const f32x4*)(xin + col + 4); }
            else { const u32x4 w = *(const u32x4*)(X + (size_t)row * D + col); x0 = (f32x4){bflo(w.x), bfhi(w.x), bflo(w.y), bfhi(w.y)}; x1 = (f32x4){bflo(w.z), bfhi(w.z), bflo(w.w), bfhi(w.w)}; }
            const float* gp = ada_gate + (size_t)row_b(row) * 24576;
            x0 += *(const f32x4*)(gp + col) * q[m][0]; x1 += *(const f32x4*)(gp + col + 4) * q[m][1];
            { bf16_t* xo_ = X + (size_t)row * D + col; const u32x4 ov_ = (u32x4){pk2(x0[0], x0[1]), pk2(x0[2], x0[3]), pk2(x1[0], x1[1]), pk2(x1[2], x1[3])};
              asm volatile("global_store_dwordx4 %0, %1, off sc1\n\ts_nop 1" :: "v"(xo_), "v"(ov_) : "memory"); } }
    }
    EPI_ALL_QUARTERS
};

struct TItem { const float* src; bf16_t* dst; int N, K; };
constexpr int TI_ADA = 4 * 3072, TI_LAYER = 5120 + 256 + 512 + 1024 + 1024 + 64 + 64;
__device__ __forceinline__ TItem tdecode(KP& p, int L, int r) {
    const float* W; bf16_t* WT; int K, N, inst = 0; size_t dsto = 0, srco = 0;
    if (L < 0) { W = p.in[I_WADA]; WT = (bf16_t*)(p.ws + WS_WT_ADA); K = 2048; N = 6144; if (L == -1) { inst = r / 3072; r %= 3072; } else inst = -2 - L; dsto = srco = (size_t)inst * K * N; }
    else if (r < 5120) { W = p.in[I_WIN]; WT = (bf16_t*)(p.ws + WS_WT_IN); K = 2048; N = INC; dsto = srco = (size_t)L * K * N; }
    else if ((r -= 5120) < 256) { W = p.in[I_WGLU]; WT = (bf16_t*)(p.ws + WS_WT_GLU); K = 1024; N = 1024; dsto = srco = (size_t)L * K * N; }
    else if ((r -= 256) < 512) { W = p.in[I_WPA]; WT = (bf16_t*)(p.ws + WS_WT_PA); K = 1024; N = 2048; dsto = srco = (size_t)L * K * N; }
    else if ((r -= 512) < 1024) { W = p.in[I_WPB]; WT = (bf16_t*)(p.ws + WS_WT_PB); K = 2048; N = 2048; dsto = srco = (size_t)L * K * N; }
    else if ((r -= 1024) < 1024) { W = p.in[I_WOUT]; WT = (bf16_t*)(p.ws + WS_WT_OUT); K = 2048; N = 2048; dsto = srco = (size_t)L * K * N; }
    else if ((r -= 1024) < 64) { W = p.in[I_WR]; WT = (bf16_t*)(p.ws + WS_WT_RG); K = 128; N = 128; inst = r / 4; r %= 4; srco = (size_t)(L * 16 + inst) * 16384; dsto = ((size_t)L * 2 + 0) * 262144 + (size_t)inst * 16384; }
    else { r -= 64; W = p.in[I_WI]; WT = (bf16_t*)(p.ws + WS_WT_RG); K = 128; N = 128; inst = r / 4; r %= 4; srco = (size_t)(L * 16 + inst) * 16384; dsto = ((size_t)L * 2 + 1) * 262144 + (size_t)inst * 16384; }
    const int nb_n = N / 64, kb = r / nb_n, nb = r % nb_n;
    TItem t; t.N = N; t.K = K; t.src = W + srco + (size_t)(kb * 64) * N + nb * 64; t.dst = WT + dsto + (size_t)(nb * 64) * K + kb * 64; return t;
}
__device__ __forceinline__ void transpose_set(KP& p, LAS unsigned char* lds, int L, int w, int nw, int first = 0, int count = -1) {
    const int lane = TID() & 63, wave = TID() >> 6;
    const int nitems = count < 0 ? (L == -1 ? TI_ADA : (L < -1 ? 3072 : TI_LAYER)) : first + count;
    LAS float* tile = (LAS float*)(lds + wave * 16640);
    int it = first + w; if (it >= nitems) return;
    TItem cur = tdecode(p, L, it);
    f32x4 v[16];
#pragma unroll
    for (int i = 0; i < 16; ++i) v[i] = *(const f32x4*)(cur.src + (size_t)((lane >> 4) + 4 * i) * cur.N + (lane & 15) * 4);
    for (;;) {
#pragma unroll
        for (int i = 0; i < 16; ++i) { LAS float* d = tile + ((lane >> 4) + 4 * i) * 65 + (lane & 15) * 4; d[0] = v[i][0]; d[1] = v[i][1]; d[2] = v[i][2]; d[3] = v[i][3]; }
        const int nit = it + nw; const bool more = nit < nitems; TItem nx = cur;
        if (more) { nx = tdecode(p, L, nit);
#pragma unroll
            for (int i = 0; i < 16; ++i) v[i] = *(const f32x4*)(nx.src + (size_t)((lane >> 4) + 4 * i) * nx.N + (lane & 15) * 4); }
        LDS_WAIT();
        const int c = lane & 7;
#pragma unroll
        for (int j = 0; j < 8; ++j) { const int n = (lane >> 3) + 8 * j; const LAS float* sp = tile + (8 * c) * 65 + n;
            u32x4 o; o.x = pk2(sp[0], sp[65]); o.y = pk2(sp[2 * 65], sp[3 * 65]); o.z = pk2(sp[4 * 65], sp[5 * 65]); o.w = pk2(sp[6 * 65], sp[7 * 65]);
            *(u32x4*)(cur.dst + (size_t)n * cur.K + 8 * c) = o; }
        LDS_WAIT();
        if (!more) break;
        cur = nx; it = nit;
    }
}

__device__ __forceinline__ void sincos_d(double x, double& s, double& c) {
    const double k = rint(x * 0.15915494309189535); const double r = x - k * 6.283185307179586476925; const double r2 = r * r;
    double as = 1.0, ac = 1.0;
#pragma unroll
    for (int n = 14; n >= 1; --n) { as = 1.0 - r2 * (1.0 / ((2.0 * n) * (2.0 * n + 1.0))) * as; ac = 1.0 - r2 * (1.0 / ((2.0 * n - 1.0) * (2.0 * n))) * ac; }
    s = r * as; c = ac;
}

__device__ __forceinline__ void phase_prologue(KP& p, LAS unsigned char* lds) {
    const int tid = TID(), lane = tid & 63, wave = tid >> 6;
    const int gw = BID() * 8 + wave, NGW = GDIM() * 8;
    for (int i = BID() * 512 + tid; i < 4 * 4096; i += GDIM() * 512) {
        const int lg = i >> 6;
        const float lr = p.in[I_LAMRE][i], li = p.in[I_LAMIM][i], dt = expf(p.in[I_LOGDT][lg]);
        const float mag = expf(lr * dt); double sd, cd; sincos_d((double)li * (double)dt, sd, cd);
        const float are = mag * (float)cd, aim = mag * (float)sd;
        float pr = are, pi = aim;
#pragma unroll
        for (int s = 0; s < 6; ++s) { const float nr = pr * pr - pi * pi, ni = 2.f * pr * pi; pr = nr; pi = ni; }
        *(f32x4*)(p.ws + WS_S5ABAR + (size_t)i * 16) = (f32x4){are, aim, pr, pi};
        const float nr = are - 1.f, ni = aim, den = lr * lr + li * li;
        const float cre = (nr * lr + ni * li) / den, cim = (ni * lr - nr * li) / den;
        const float* bre = p.in[I_BRE] + (size_t)i * 16; const float* bim = p.in[I_BIM] + (size_t)i * 16;
        bf16_t* bbf = (bf16_t*)(p.ws + WS_S5BBR);
        const int pst = i & 63;
#pragma unroll
        for (int c4 = 0; c4 < 4; ++c4) { const f32x4 br = *(const f32x4*)(bre + 4 * c4), bi = *(const f32x4*)(bim + 4 * c4);
            const f32x4 vr = cre * br - cim * bi, vi = cre * bi + cim * br;
#pragma unroll
            for (int e = 0; e < 4; ++e) { const int c = 4 * c4 + e, half = c >> 3, j = c & 7;
#pragma unroll
                for (int part = 0; part < 2; ++part) { const int n = 2 * pst + part, nb = n >> 4, nl = n & 15;
                    bbf[((size_t)(lg * 8 + nb) * 32 + half * 16 + nl) * 8 + j] = (bf16_t)(pk2(part ? vi[e] : vr[e], 0.f) & 0xffffu); } } }
    }
    for (int i = BID() * 512 + tid; i < 256 * D / 4; i += GDIM() * 512) {
        const int row = i >> 9, c4 = (i & 511) * 4;
        f32x4 v = (f32x4){0.f, 0.f, 0.f, 0.f};
        if (row < 4) v = *(const f32x4*)(p.in[I_CP] + (size_t)row * D + c4); else if (row < 132) v = *(const f32x4*)(p.in[I_CS] + (size_t)(row - 4) * D + c4);
        *(u32x2*)(p.ws + WS_CB + ((size_t)row * D + c4) * 2) = (u32x2){pk2(v[0], v[1]), pk2(v[2], v[3])};
    }
    transpose_set(p, lds, GDIM() == 256 ? -2 : -1, gw, NGW);
    if (GDIM() != 256) transpose_set(p, lds, 0, gw, NGW); else transpose_set(p, lds, 0, gw, NGW, 0, 5120);
}

__device__ __forceinline__ void phase_norm(KP& p, int l, bool final_norm, int w0 = -1, int nw = 0, int r0 = 0, int r1 = MR) {
    const int lane = TID() & 63, wave = TID() >> 6;
    const float* ada = (const float*)(p.ws + WS_ADA);
    const bool from_in = !final_norm && l == 0;
    if (w0 < 0) { w0 = BID() * 8 + wave; nw = GDIM() * 8; }
    for (int row = r0 + w0; row < r1; row += nw) {
        f32x4 v[8]; float ss = 0.f;
        if (from_in) { const float* xr = row < NP ? p.in[I_XP] + (size_t)row * D : p.in[I_XS] + (size_t)(row - NP) * D;
#pragma unroll
            for (int j = 0; j < 8; ++j) v[j] = *(const f32x4*)(xr + (lane + 64 * (j >> 1)) * 8 + (j & 1) * 4); }
        else { const bf16_t* xr = (const bf16_t*)(p.ws + WS_X) + (size_t)row * D;
#pragma unroll
            for (int j2 = 0; j2 < 4; ++j2) { const u32x4 w = *(const u32x4*)(xr + (lane + 64 * j2) * 8);
                v[2 * j2] = (f32x4){bflo(w.x), bfhi(w.x), bflo(w.y), bfhi(w.y)}; v[2 * j2 + 1] = (f32x4){bflo(w.z), bfhi(w.z), bflo(w.w), bfhi(w.w)}; } }
#pragma unroll
        for (int j = 0; j < 8; ++j) ss += (v[j][0] * v[j][0] + v[j][1] * v[j][1]) + (v[j][2] * v[j][2] + v[j][3] * v[j][3]);
        const float rstd = 1.0f / sqrtf(wave_sum(ss) * (1.f / D) + EPS);
        if (final_norm) {
#pragma unroll
            for (int j = 0; j < 8; ++j) { const int c = (lane + 64 * (j >> 1)) * 8 + (j & 1) * 4; *(f32x4*)(p.out + (size_t)row * D + c) = v[j] * rstd * *(const f32x4*)(p.in[I_FG] + c); }
        } else {
            const float* ar = ada + (size_t)row_b(row) * 24576 + l * 6144; const float* ng = p.in[I_NG] + l * D;
            bf16_t* xo = (bf16_t*)(p.ws + WS_XN) + (size_t)row * D;
#pragma unroll
            for (int j2 = 0; j2 < 4; ++j2) { const int c = (lane + 64 * j2) * 8;
                const f32x4 y0 = v[2 * j2] * rstd * *(const f32x4*)(ng + c) * (1.f + *(const f32x4*)(ar + 2048 + c)) + *(const f32x4*)(ar + c);
                const f32x4 y1 = v[2 * j2 + 1] * rstd * *(const f32x4*)(ng + c + 4) * (1.f + *(const f32x4*)(ar + 2048 + c + 4)) + *(const f32x4*)(ar + c + 4);
                *(u32x4*)(xo + c) = (u32x4){pk2(y0[0], y0[1]), pk2(y0[2], y0[3]), pk2(y1[0], y1[1]), pk2(y1[2], y1[3])}; }
        }
    }
}

constexpr int S5_BU = 0, S5_HB = 8448, S5_YB = 8448 + 5376, S5_WAVE_BYTES = 8448 + 5376 + 2048;
template <bool OUT>
__device__ __forceinline__ void phase_s5(KP& p, int l, LAS unsigned char* lds) {
    const int lane = TID() & 63, wave = __builtin_amdgcn_readfirstlane(TID() >> 6), fr = lane & 15, fq = lane >> 4;
    LAS float* bu = (LAS float*)(lds + wave * S5_WAVE_BYTES + S5_BU);
    LAS unsigned char* hb = lds + wave * S5_WAVE_BYTES + S5_HB;
    LAS bf16_t* yb = (LAS bf16_t*)(lds + wave * S5_WAVE_BYTES + S5_YB);
    const bf16_t* PROJ = (const bf16_t*)(p.ws + WS_PROJ);
    if (OUT) { if (lane < 16) { *(LAS u32x4*)(hb + lane * 336 + 288) = (u32x4){0u, 0u, 0u, 0u}; *(LAS u32x4*)(hb + lane * 336 + 304) = (u32x4){0u, 0u, 0u, 0u}; } }
    const int nitems = OUT ? NTILE * 64 : 128 * 64;
    int gprev = -1;
    bf16x8 bf[8]; f32x4 ab = (f32x4){0.f, 0.f, 0.f, 0.f}; bf16x8 cf[5];
    for (int it = BID() * 8 + wave; it < nitems; it += GDIM() * 8) {
        const int tI = it >> 6, g = it & 63; const bool prompt = tI < 128; const int row0 = tI * 64;
        if (g != gprev) { gprev = g;
#pragma unroll
        for (int nb = 0; nb < 8; ++nb) { u32x4 w = (u32x4){0u, 0u, 0u, 0u};
            if (lane < 32) w = *(const u32x4*)(p.ws + WS_S5BBR + ((size_t)((l * 64 + g) * 8 + nb) * 32 + lane) * 16);
            bf[nb] = __builtin_bit_cast(bf16x8, w); }
        ab = *(const f32x4*)(p.ws + WS_S5ABAR + ((size_t)(l * 64 + g) * 64 + lane) * 16);
        if (OUT) { const float* cre = p.in[I_CRE] + (((size_t)l * 64 + g) * 16 + fr) * 64; const float* cim = p.in[I_CIM] + (((size_t)l * 64 + g) * 16 + fr) * 64;
#pragma unroll
            for (int kk = 0; kk < 4; ++kk) { const f32x4 a = *(const f32x4*)(cre + 16 * kk + 4 * fq), b = *(const f32x4*)(cim + 16 * kk + 4 * fq);
                u32x4 w; w.x = pk2(a[0], -b[0]); w.y = pk2(a[1], -b[1]); w.z = pk2(a[2], -b[2]); w.w = pk2(a[3], -b[3]);
                cf[kk] = __builtin_bit_cast(bf16x8, w); }
            const float dval = p.in[I_S5D][l * S5W + g * 16 + fr];
            const unsigned dbf = pk2(dval, 0.f) & 0xffffu; const int jj = fr & 7; const bool mine = (fq == (fr >> 3));
            u32x4 w; w.x = (mine && (jj >> 1) == 0) ? (dbf << (16 * (jj & 1))) : 0u; w.y = (mine && (jj >> 1) == 1) ? (dbf << (16 * (jj & 1))) : 0u;
            w.z = (mine && (jj >> 1) == 2) ? (dbf << (16 * (jj & 1))) : 0u; w.w = (mine && (jj >> 1) == 3) ? (dbf << (16 * (jj & 1))) : 0u;
            cf[4] = __builtin_bit_cast(bf16x8, w); }
        }
        float hr = 0.f, hi = 0.f;
        if (OUT && prompt) { const int b = tI >> 5, k = tI & 31;
            const float* lr = (const float*)(p.ws + WS_S5LOCR) + (size_t)(b * 32) * 4096 + g * 64 + lane; const float* li = (const float*)(p.ws + WS_S5LOCI) + (size_t)(b * 32) * 4096 + g * 64 + lane;
            for (int jb = 0; jb < k; jb += 8) { float sr[8], si[8];
#pragma unroll
                for (int u = 0; u < 8; ++u) { const int j = (jb + u) < 31 ? (jb + u) : 31; sr[u] = lr[(size_t)j * 4096]; si[u] = li[(size_t)j * 4096]; }
#pragma unroll
                for (int u = 0; u < 8; ++u) { const float nr = ab[2] * hr - ab[3] * hi + sr[u], ni = ab[2] * hi + ab[3] * hr + si[u]; const bool on = (jb + u) < k; hr = on ? nr : hr; hi = on ? ni : hi; } } }
        u32x4 unext = (u32x4){0u, 0u, 0u, 0u};
        if (lane < 32) unext = *(const u32x4*)(PROJ + (size_t)(row0 + fr) * INC + g * 16 + 8 * fq);
        for (int sub = 0; sub < 4; ++sub) {
            const u32x4 uw = unext;
            if (sub < 3 && lane < 32) unext = *(const u32x4*)(PROJ + (size_t)(row0 + (sub + 1) * 16 + fr) * INC + g * 16 + 8 * fq);
            const bf16x8 ua = __builtin_bit_cast(bf16x8, uw);
            f32x4 dd[8];
#pragma unroll
            for (int nb = 0; nb < 8; ++nb) dd[nb] = __builtin_amdgcn_mfma_f32_16x16x32_bf16(ua, bf[nb], (f32x4){0.f, 0.f, 0.f, 0.f}, 0, 0, 0);
            asm volatile("s_nop 15\n\ts_nop 15" : "+v"(dd[0]), "+v"(dd[1]), "+v"(dd[2]), "+v"(dd[3]), "+v"(dd[4]), "+v"(dd[5]), "+v"(dd[6]), "+v"(dd[7]));
#pragma unroll
            for (int nb = 0; nb < 8; ++nb)
#pragma unroll
                for (int r = 0; r < 4; ++r) bu[(4 * fq + r) * 132 + 16 * nb + fr] = dd[nb][r];
            if (OUT) { if (lane < 32) *(LAS u32x4*)(hb + fr * 336 + (128 + 8 * fq) * 2) = uw; }
            LDS_WAIT();
#pragma unroll
            for (int tt = 0; tt < 16; ++tt) { const int t = sub * 16 + tt;
                if (OUT) { if (!prompt && (t & 3) == 0) { const size_t si = (((size_t)l * 128 + (tI - 128) * 16 + (t >> 2)) * 64 + g) * 64 + lane; hr = p.in[I_S5RE][si]; hi = p.in[I_S5IM][si]; } }
                const f32x2 bv = *(const LAS f32x2*)(bu + tt * 132 + 2 * lane);
                const float nr = ab[0] * hr - ab[1] * hi + bv[0], ni = ab[0] * hi + ab[1] * hr + bv[1]; hr = nr; hi = ni;
                if (OUT) { *(LAS unsigned*)(hb + tt * 336 + lane * 4) = pk2(hr, hi);
                    if (!prompt && (t & 3) == 3) { const size_t si = (((size_t)l * 128 + (tI - 128) * 16 + (t >> 2)) * 64 + g) * 64 + lane; p.out[O_S5RS + si] = hr; p.out[O_S5IS + si] = hi; } }
            }
            if (OUT) {
                LDS_WAIT();
                f32x4 acc = (f32x4){0.f, 0.f, 0.f, 0.f};
#pragma unroll
                for (int kk = 0; kk < 5; ++kk) { const bf16x8 a = *(const LAS bf16x8*)(hb + fr * 336 + (32 * kk + 8 * fq) * 2); acc = __builtin_amdgcn_mfma_f32_16x16x32_bf16(a, cf[kk], acc, 0, 0, 0); }
                asm volatile("s_nop 15" : "+v"(acc));
#pragma unroll
                for (int r = 0; r < 4; ++r) { const int t = sub * 16 + fq * 4 + r; float y = acc[r];
                    { const float tq = __builtin_amdgcn_rcpf(__builtin_fabsf(y) * 0.2316418882f + 1.0f);
                      float q = tq * 0.5307027145f + (-0.7265760135f); q = q * tq + 0.7107068705f; q = q * tq + (-0.142248368f); q = q * tq + 0.127414796f; q = q * tq;
                      const float m = y * (q * __builtin_amdgcn_exp2f(y * y * (-0.72134752044f))); y = y < 0.f ? m : y - m; }
                    yb[t * 16 + fr] = (bf16_t)(pk2(y, 0.f) & 0xffffu); }
            }
            LDS_WAIT();
        }
        if (OUT) {
            if (prompt && (tI & 31) == 31) { const size_t si = (((size_t)l * 4 + (tI >> 5)) * 64 + g) * 64 + lane; p.out[O_S5RP + si] = hr; p.out[O_S5IP + si] = hi; }
            const LAS u32x4* sy = (const LAS u32x4*)(yb + lane * 16); const u32x4 o0 = sy[0], o1 = sy[1];
            u32x4* d = (u32x4*)((bf16_t*)(p.ws + WS_YS5) + (size_t)(row0 + lane) * S5W + g * 16); d[0] = o0; d[1] = o1;
            LDS_WAIT();
        } else {
            ((float*)(p.ws + WS_S5LOCR))[(size_t)tI * 4096 + g * 64 + lane] = hr;
            ((float*)(p.ws + WS_S5LOCI))[(size_t)tI * 4096 + g * 64 + lane] = hi;
        }
    }
}

constexpr int RG_WL = 0, RG_AT = 69632, RG_AB = 87040, RG_BB = 120832;
__device__ __forceinline__ void phase_rg_local(KP& p, int l, LAS unsigned char* lds) {
    const int tid = TID(), lane = tid & 63, wave = tid >> 6, fr = lane & 15, fq = lane >> 4;
    const int nbh = GDIM() >> 4; if (BID() >= nbh * 16) return;
    const int h = BID() & 15;
    const bf16_t* PROJ = (const bf16_t*)(p.ws + WS_PROJ);
    bf16_t* YB = (bf16_t*)(p.ws + WS_YB); bf16_t* PBUF = (bf16_t*)(p.ws + WS_PB);
    { const bf16_t* w = (const bf16_t*)(p.ws + WS_WT_RG) + (size_t)l * 2 * 262144 + (size_t)h * 16384;
#pragma unroll
        for (int gsel = 0; gsel < 2; ++gsel)
#pragma unroll
            for (int i = 0; i < 4; ++i) { const int idx = tid + 512 * i, n = idx >> 4, kc = (idx & 15) * 8;
                *(LAS u32x4*)(lds + RG_WL + gsel * 34816 + n * 272 + kc * 2) = *(const u32x4*)(w + (size_t)gsel * 262144 + n * 128 + kc); } }
    const int cp = tid & 63, rg = tid >> 6, chg2 = h * 128 + 2 * cp;
    f32x2 cw[4];
#pragma unroll
    for (int k = 0; k < 4; ++k) cw[k] = *(const f32x2*)(p.in[I_CW] + (size_t)(l * 4 + k) * D + chg2);
    const f32x2 cbias = *(const f32x2*)(p.in[I_CBIAS] + (size_t)l * D + chg2);
    const int mt = (wave & 3) * 16, ch0 = (wave >> 2) * 64;
    float sp8[4], brr[4], bii[4];
#pragma unroll
    for (int nt = 0; nt < 4; ++nt) { const int cg_ = h * 128 + ch0 + nt * 16 + fr; brr[nt] = p.in[I_BR][l * D + cg_]; bii[nt] = p.in[I_BI][l * D + cg_]; sp8[nt] = -8.f * log1pf(expf(-p.in[I_LAM][l * D + cg_])); }
    LAS unsigned char* At = lds + RG_AT; LAS float* abuf = (LAS float*)(lds + RG_AB); LAS float* bbuf = (LAS float*)(lds + RG_BB);
    u32x4 xq[3];
#define RG_PREFETCH(t) { _Pragma("unroll") for (int i = 0; i < 3; ++i) { const int idx = tid + 512 * i, row = (idx >> 4) - 3, chunk = idx & 15; \
        const bool ok = idx < 1072 && (row >= 0 || ((t) < 128 && ((t) & 31) > 0)); xq[i] = (u32x4){0u, 0u, 0u, 0u}; \
        if (ok) xq[i] = *(const u32x4*)(PROJ + (size_t)((t) * 64 + row) * INC + 2048 + h * 128 + chunk * 8); } }
    int tI = BID() >> 4;
    if (tI < NTILE) RG_PREFETCH(tI);
    for (; tI < NTILE; tI += nbh) {
        const bool prompt = tI < 128; const int row0 = tI * 64;
#pragma unroll
        for (int i = 0; i < 3; ++i) { const int idx = tid + 512 * i; if (idx < 1072) *(LAS u32x4*)(lds + RG_BB + idx * 16) = xq[i]; }
        { const int nI = tI + nbh; if (nI < NTILE) RG_PREFETCH(nI); }
        __syncthreads();
        {
            const LAS unsigned* xr = (const LAS unsigned*)(lds + RG_BB) + cp;
            unsigned w = xr[(8 * rg + 0) * 64]; f32x2 m3 = (f32x2){bflo(w), bfhi(w)}; w = xr[(8 * rg + 1) * 64]; f32x2 m2 = (f32x2){bflo(w), bfhi(w)}; w = xr[(8 * rg + 2) * 64]; f32x2 m1 = (f32x2){bflo(w), bfhi(w)};
#pragma unroll
            for (int i = 0; i < 8; ++i) { const int r = 8 * rg + i; const int bs = (tI - 128) * 16 + (r >> 2);
                if (!prompt && (i & 3) == 0) { const float* cb = p.in[I_CONV] + ((size_t)(l * 128 + bs) * 3) * D + chg2; m3 = *(const f32x2*)cb; m2 = *(const f32x2*)(cb + D); m1 = *(const f32x2*)(cb + 2 * D); }
                w = xr[(r + 3) * 64]; const f32x2 x = (f32x2){bflo(w), bfhi(w)};
                const f32x2 cv = cbias + cw[0] * m3 + cw[1] * m2 + cw[2] * m1 + cw[3] * x;
                *(LAS unsigned*)(At + r * 272 + cp * 4) = pk2(cv[0], cv[1]);
                if (prompt) { if ((tI & 31) == 31 && r >= 61) *(f32x2*)(p.out + O_CONVP + ((size_t)(l * 4 + (tI >> 5)) * 3 + (r - 61)) * D + chg2) = x; }
                else if ((i & 3) != 0) *(f32x2*)(p.out + O_CONVS + ((size_t)(l * 128 + bs) * 3 + ((i & 3) - 1)) * D + chg2) = x;
                m3 = m2; m2 = m1; m1 = x; }
        }
        __syncthreads();
        {
            bf16x8 a[4];
#pragma unroll
            for (int kk = 0; kk < 4; ++kk) a[kk] = *(const LAS bf16x8*)(At + (mt + fr) * 272 + (32 * kk + 8 * fq) * 2);
#pragma unroll
            for (int nt = 0; nt < 4; ++nt) {
                f32x4 ar = (f32x4){0.f, 0.f, 0.f, 0.f}, ai = (f32x4){0.f, 0.f, 0.f, 0.f};
#pragma unroll
                for (int kk = 0; kk < 4; ++kk) {
                    const bf16x8 br = *(const LAS bf16x8*)(lds + RG_WL + (ch0 + nt * 16 + fr) * 272 + (32 * kk + 8 * fq) * 2);
                    const bf16x8 bi = *(const LAS bf16x8*)(lds + RG_WL + 34816 + (ch0 + nt * 16 + fr) * 272 + (32 * kk + 8 * fq) * 2);
                    ar = __builtin_amdgcn_mfma_f32_16x16x32_bf16(a[kk], br, ar, 0, 0, 0); ai = __builtin_amdgcn_mfma_f32_16x16x32_bf16(a[kk], bi, ai, 0, 0, 0); }
                asm volatile("s_nop 15" : "+v"(ar), "+v"(ai));
                const int c = ch0 + nt * 16 + fr;
#pragma unroll
                for (int r = 0; r < 4; ++r) { const int row = mt + fq * 4 + r;
                    const float rr = sigm(ar[r] + brr[nt]), gi = sigm(ai[r] + bii[nt]);
                    const float la = sp8[nt] * rr, av = __expf(la), x2 = 2.f * la;
                    const float ser = -x2 * (1.f + x2 * (0.5f + x2 * (0.16666667f + x2 * (0.041666668f + x2 * 0.0083333338f))));
                    const float m2v = x2 > -0.25f ? ser : 1.f - av * av;
                    const float cv = bf1(*(const LAS bf16_t*)(At + row * 272 + c * 2));
                    abuf[row * 132 + c] = av; bbuf[row * 132 + c] = sqrtf(m2v) * gi * cv; }
            }
        }
        __syncthreads();
        if (prompt) {
            f32x2 hl[8], pl[8]; f32x2 hh = (f32x2){0.f, 0.f}, pp = (f32x2){1.f, 1.f};
#pragma unroll
            for (int i = 0; i < 8; ++i) { const int r = rg * 8 + i; const f32x2 av = *(const LAS f32x2*)(abuf + r * 132 + 2 * cp), bv = *(const LAS f32x2*)(bbuf + r * 132 + 2 * cp); hh = av * hh + bv; pp = pp * av; hl[i] = hh; pl[i] = pp; }
            LAS f32x4* comb = (LAS f32x4*)(lds + RG_AT);
            comb[rg * 64 + cp] = (f32x4){pp[0], hh[0], pp[1], hh[1]};
            __syncthreads();
            f32x2 Hp = (f32x2){0.f, 0.f}, Pp = (f32x2){1.f, 1.f};
            for (int s2 = 0; s2 < rg; ++s2) { const f32x4 c = comb[s2 * 64 + cp]; Hp = (f32x2){c[0], c[2]} * Hp + (f32x2){c[1], c[3]}; Pp = Pp * (f32x2){c[0], c[2]}; }
#pragma unroll
            for (int i = 0; i < 8; ++i) { const size_t o = (size_t)(row0 + rg * 8 + i) * D + chg2;
                const f32x2 hv = hl[i] + pl[i] * Hp, pv = pl[i] * Pp;
                *(unsigned*)(YB + o) = pk2(hv[0], hv[1]); *(unsigned*)(PBUF + o) = pk2(pv[0], pv[1]);
                if (rg == 7 && i == 7) *(f32x4*)(p.ws + WS_RGEND + ((size_t)tI * D + chg2) * 8) = (f32x4){pv[0], hv[0], pv[1], hv[1]}; }
        } else {
#pragma unroll
            for (int s2 = 0; s2 < 2; ++s2) { const int bs = (tI - 128) * 16 + rg * 2 + s2;
                f32x2 hh = *(const f32x2*)(p.in[I_RGH] + ((size_t)l * 128 + bs) * D + chg2);
#pragma unroll
                for (int tt = 0; tt < 4; ++tt) { const int r = rg * 8 + s2 * 4 + tt; hh = *(const LAS f32x2*)(abuf + r * 132 + 2 * cp) * hh + *(const LAS f32x2*)(bbuf + r * 132 + 2 * cp);
                    const unsigned z = *(const unsigned*)(PROJ + (size_t)(row0 + r) * INC + 4096 + chg2);
                    *(unsigned*)(YB + (size_t)(row0 + r) * D + chg2) = pk2(hh[0] * bflo(z), hh[1] * bfhi(z)); }
                *(f32x2*)(p.out + O_RGHS + ((size_t)l * 128 + bs) * D + chg2) = hh; }
        }
        __syncthreads();
    }
#undef RG_PREFETCH
}
__device__ __forceinline__ void phase_rg_fix(KP& p, int l) {
    const int tid = TID();
    const bf16_t* PROJ = (const bf16_t*)(p.ws + WS_PROJ); bf16_t* YB = (bf16_t*)(p.ws + WS_YB); const bf16_t* PBUF = (const bf16_t*)(p.ws + WS_PB);
    for (int it = BID(); it < 256; it += GDIM()) {
        const int tI = it >> 1, chg = (it & 1) * 1024 + tid * 2, b = tI >> 5, k = tI & 31;
        float H0 = 0.f, H1 = 0.f;
        for (int jb = 0; jb < k; jb += 8) { f32x4 e[8];
#pragma unroll
            for (int u = 0; u < 8; ++u) { const int j = (jb + u) < 31 ? (jb + u) : 31; e[u] = *(const f32x4*)(p.ws + WS_RGEND + ((size_t)(b * 32 + j) * D + chg) * 8); }
#pragma unroll
            for (int u = 0; u < 8; ++u) { const bool on = (jb + u) < k; H0 = on ? e[u][0] * H0 + e[u][1] : H0; H1 = on ? e[u][2] * H1 + e[u][3] : H1; } }
        float h0 = 0.f, h1 = 0.f;
#pragma unroll 16
        for (int t = 0; t < 64; ++t) { const size_t o = (size_t)(tI * 64 + t) * D + chg;
            const unsigned hv = *(const unsigned*)(YB + o), pv = *(const unsigned*)(PBUF + o), zv = *(const unsigned*)(PROJ + (size_t)(tI * 64 + t) * INC + 4096 + chg);
            h0 = bflo(hv) + bflo(pv) * H0; h1 = bfhi(hv) + bfhi(pv) * H1;
            *(unsigned*)(YB + o) = pk2(h0 * bflo(zv), h1 * bfhi(zv)); }
        if (k == 31) *(f32x2*)(p.out + O_RGHP + ((size_t)l * 4 + b) * D + chg) = (f32x2){h0, h1};
    }
}


#define XB_TMO      128
#define XB_XCNT(j)  (256  + 64 * (j))
#define XB_XSUB(j)  (1280 + 64 * (j))
#define XB_XGEN(j)  (2304 + 64 * (j))
#define XB_TOP      3328
#define XB_TOPGEN   3392
#define XCD_BAR_WORDS 3456
#define XB_SPIN_CAP (1u << 23)
__device__ __forceinline__ unsigned xb_ld(unsigned* p)              { return __hip_atomic_load(p, __ATOMIC_RELAXED, __HIP_MEMORY_SCOPE_AGENT); }
__device__ __forceinline__ unsigned xb_add(unsigned* p, unsigned v) { return __hip_atomic_fetch_add(p, v, __ATOMIC_RELAXED, __HIP_MEMORY_SCOPE_AGENT); }
__device__ __forceinline__ unsigned xb_xcc_id() { return (unsigned)__builtin_amdgcn_s_getreg((3 << 11) | 20) & 0xFu; }
#define XB_SPIN(cond, bar) do { unsigned _sp = 0; while (cond) { __builtin_amdgcn_s_sleep(1); \
    if ((++_sp & 255u) == 0u) { if (xb_ld(&(bar)[XB_TMO])) break; if (_sp > XB_SPIN_CAP) { atomicAdd(&(bar)[XB_TMO], 1u); break; } } } } while (0)
__device__ __forceinline__ void xcd_barrier_complete(unsigned* bar, unsigned x, unsigned& nloc, unsigned& nx) {
    const unsigned G = gridDim.x;
    unsigned sum, cnt, mine, sp = 0u;
    for (;;) {
        sum = 0u; cnt = 0u; mine = 0u;
#pragma unroll
        for (unsigned j = 0; j < 16; ++j) { const unsigned c = xb_ld(&bar[XB_XCNT(j)]); sum += c; cnt += (c > 0u) ? 1u : 0u; mine = (j == x) ? c : mine; }
        if (sum == G) break;
        __builtin_amdgcn_s_sleep(1);
        if ((++sp & 255u) == 0u) { if (xb_ld(&bar[XB_TMO])) break; if (sp > XB_SPIN_CAP) { atomicAdd(&bar[XB_TMO], 1u); break; } }
    }
    nloc = mine > 0u ? mine : 1u; nx = cnt > 0u ? cnt : 1u;
}
__device__ __forceinline__ void xcd_barrier(unsigned* bar, volatile LAS unsigned* st) {
    asm volatile("s_waitcnt vmcnt(0)" ::: "memory");
    __syncthreads();
    if (threadIdx.x == 0) {
        const unsigned x = xb_xcc_id();
        __builtin_amdgcn_s_waitcnt(0);
        unsigned nloc = st[0], nx = st[1];
        if (nloc == 0u) { xcd_barrier_complete(bar, x, nloc, nx); st[0] = nloc; st[1] = nx; }
        const unsigned old = xb_add(&bar[XB_XSUB(x)], 1u);
        const unsigned gen = old / nloc;
        if (old + 1u == (gen + 1u) * nloc) {
            __builtin_amdgcn_fence(__ATOMIC_RELEASE, "agent");
            asm volatile("s_waitcnt vmcnt(0)" ::: "memory");
            const unsigned og = xb_add(&bar[XB_TOP], 1u);
            const unsigned tg = og / nx;
            if (og + 1u == (tg + 1u) * nx) xb_add(&bar[XB_TOPGEN], 1u);
            else XB_SPIN(xb_ld(&bar[XB_TOPGEN]) == tg, bar);
            __builtin_amdgcn_fence(__ATOMIC_ACQUIRE, "agent");
            xb_add(&bar[XB_XGEN(x)], 1u);
            asm volatile("s_waitcnt vmcnt(0)" ::: "memory");
        } else {
            XB_SPIN(xb_ld(&bar[XB_XGEN(x)]) == gen, bar);
            __builtin_amdgcn_fence(__ATOMIC_ACQUIRE, "agent");
            asm volatile("s_waitcnt vmcnt(0)" ::: "memory");
        }
    }
    __syncthreads();
}

#ifndef PH_MASK
#define PH_MASK 0x7ff
#endif
#define PH_ON(b) ((PH_MASK >> (b)) & 1)
#ifndef REP_MASK
#define REP_MASK 0
#endif
#define PH_REP(b) for (int rep_ = 0; rep_ < 1 + ((REP_MASK >> (b)) & 1); ++rep_)
__device__ __forceinline__ void run_phase(KP& p, int ph, LAS unsigned char* lds) {
    float* slab = (float*)(p.ws + WS_SLAB); unsigned* cnt = (unsigned*)(p.ws + WS_CNT) + ph * 128;
    if (ph == 0) { if (PH_ON(0)) PH_REP(0) { phase_prologue(p, lds); __syncthreads(); } return; }
    if (ph == 1) { if (PH_ON(1)) PH_REP(1) { EpiAda e; e.C = (float*)(p.ws + WS_ADA); e.bias = p.in[I_BADA];
        pg8::gemm_phase(lds, (const bf16_t*)(p.ws + WS_CB), (const bf16_t*)(p.ws + WS_WT_ADA), 256, GDIM() == 256 ? 6144 : 24576, 2048, e, slab, cnt);
        if (GDIM() == 256 && BID() >= 192) transpose_set(p, lds, 0, (BID() - 192) * 8 + (TID() >> 6), 64 * 8, 5120, TI_LAYER - 5120); } return; }
    if (ph == N_PHASES - 1) { if (PH_ON(2) && GDIM() != 256) phase_norm(p, 0, true); return; }
    const int l = (ph - 2) / 7, s = (ph - 2) % 7;
    switch (s) {
    case 0: if (PH_ON(2) && (l == 0 || GDIM() != 256)) PH_REP(2) phase_norm(p, l, false); break;
    case 1: if (PH_ON(3)) PH_REP(3) { EpiProj e; e.O = (bf16_t*)(p.ws + WS_PROJ); e.bias = p.in[I_BIN] + (size_t)l * INC;
        const int G = GDIM(), bid = BID(); const int Gg = (l + 1 < DEPTH && G == 256) ? 227 : G;
        if (bid < Gg) pg8::gemm_phase(lds, (const bf16_t*)(p.ws + WS_XN), (const bf16_t*)(p.ws + WS_WT_IN) + (size_t)l * INC * D, MR, INC, D, e, slab, cnt, Gg, bid);
        else { transpose_set(p, lds, l + 1, (bid - Gg) * 8 + (TID() >> 6), (G - Gg) * 8); transpose_set(p, lds, -2 - (l + 1), (bid - Gg) * 8 + (TID() >> 6), (G - Gg) * 8); }
        if (l + 1 < DEPTH && Gg == G) transpose_set(p, lds, l + 1, bid * 8 + (TID() >> 6), G * 8); } break;
    case 2: if (PH_ON(4)) PH_REP(4) { phase_s5<false>(p, l, lds); __syncthreads(); } if (PH_ON(9)) PH_REP(9) { phase_rg_local(p, l, lds); __syncthreads(); } break;
    case 3: if (PH_ON(5)) PH_REP(5) { phase_s5<true>(p, l, lds); __syncthreads(); } if (PH_ON(10)) phase_rg_fix(p, l); break;
    case 4: if (PH_ON(6)) PH_REP(6) {
        const int G = GDIM(), bid = BID(); const int off = (G >= 136 + 16) ? G - 136 : 0; const bool chain = (G == 256);
        unsigned* cg2 = cnt + 102;
        if (bid >= off) { EpiGlu e; e.O = (bf16_t*)(p.ws + WS_YA); e.Y = (const bf16_t*)(p.ws + WS_YS5); e.PROJ = (const bf16_t*)(p.ws + WS_PROJ); e.bias = p.in[I_BGLU] + (size_t)l * S5W;
            pg8::gemm_phase(lds, (const bf16_t*)(p.ws + WS_YS5), (const bf16_t*)(p.ws + WS_WT_GLU) + (size_t)l * 1024 * 1024, MR, 1024, 1024, e, slab, cnt, G - off, bid - off);
            if (chain && TID() == 0) (void)__hip_atomic_fetch_add(cg2, 1u, __ATOMIC_RELAXED, __HIP_MEMORY_SCOPE_AGENT); }
        EpiPa eb; eb.T = (bf16_t*)(p.ws + WS_MTMP); eb.PROJ = (const bf16_t*)(p.ws + WS_PROJ); eb.goff = 8192;
        pg8::gemm_phase(lds, (const bf16_t*)(p.ws + WS_YB), (const bf16_t*)(p.ws + WS_WT_PB) + (size_t)l * 2048 * 2048, MR, 2048, 2048, eb, slab, cnt);
        if (chain) {
            asm volatile("s_waitcnt vmcnt(0)" ::: "memory");
            if (TID() == 0) { unsigned sp = 0; while (__hip_atomic_load(cg2, __ATOMIC_RELAXED, __HIP_MEMORY_SCOPE_AGENT) < 136u && ++sp < (1u << 24)) __builtin_amdgcn_s_sleep(1);
                __builtin_amdgcn_fence(__ATOMIC_ACQUIRE, "agent"); asm volatile("s_waitcnt vmcnt(0)" ::: "memory"); }
            __syncthreads();
            EpiPb ea; ea.O = (bf16_t*)(p.ws + WS_MERGED); ea.T = (const bf16_t*)(p.ws + WS_MTMP); ea.PROJ = (const bf16_t*)(p.ws + WS_PROJ); ea.goff = 6144;
            pg8::gemm_phase(lds, (const bf16_t*)(p.ws + WS_YA), (const bf16_t*)(p.ws + WS_WT_PA) + (size_t)l * 2048 * 1024, MR, 2048, 1024, ea, slab + (size_t)64 * 65536, cnt + 32);
            if (l + 1 < DEPTH && bid >= 64 && bid < 120) {
                EpiAda en; en.C = (float*)(p.ws + WS_ADA) + (l + 1) * 6144; en.bias = p.in[I_BADA] + (l + 1) * 6144;
                pg8::gemm_phase(lds, (const bf16_t*)(p.ws + WS_CB), (const bf16_t*)(p.ws + WS_WT_ADA) + (size_t)(l + 1) * 6144 * 2048, 256, 6144, 2048, en, slab + (size_t)128 * 65536, cnt + 64, 56, bid - 64); } } } break;
    case 5: if (PH_ON(7) && GDIM() != 256) PH_REP(7) { EpiPb ea; ea.O = (bf16_t*)(p.ws + WS_MERGED); ea.T = (const bf16_t*)(p.ws + WS_MTMP); ea.PROJ = (const bf16_t*)(p.ws + WS_PROJ); ea.goff = 6144;
        pg8::gemm_phase(lds, (const bf16_t*)(p.ws + WS_YA), (const bf16_t*)(p.ws + WS_WT_PA) + (size_t)l * 2048 * 1024, MR, 2048, 1024, ea, slab, cnt); } break;
    case 6: if (PH_ON(8)) { EpiOut e; e.X = (bf16_t*)(p.ws + WS_X); e.xp = p.in[I_XP]; e.xs = p.in[I_XS]; e.ada_gate = (const float*)(p.ws + WS_ADA) + l * 6144 + 4096; e.first = (l == 0);
        const int hidden = (GDIM() == 256); e.hidden = hidden; e.cfull = cnt + 100; e.cpiece = cnt + 101;
        pg8::gemm_phase(lds, (const bf16_t*)(p.ws + WS_MERGED), (const bf16_t*)(p.ws + WS_WT_OUT) + (size_t)l * 2048 * 2048, MR, 2048, 2048, e, slab, cnt);
        if (hidden && BID() >= 64) {
            const int w = (BID() - 64) * 8 + (TID() >> 6), nw = 192 * 8; const bool fin = (l + 1 == DEPTH);
            if (TID() == 0) { unsigned sp = 0; while (__hip_atomic_load(e.cfull, __ATOMIC_RELAXED, __HIP_MEMORY_SCOPE_AGENT) < 256u && ++sp < (1u << 24)) __builtin_amdgcn_s_sleep(1);
                __builtin_amdgcn_fence(__ATOMIC_ACQUIRE, "agent"); asm volatile("s_waitcnt vmcnt(0)" ::: "memory"); }
            __syncthreads();
            phase_norm(p, l + 1, fin, w, nw, 0, NP);
            if (TID() == 0) { unsigned sp = 0; while (__hip_atomic_load(e.cpiece, __ATOMIC_RELAXED, __HIP_MEMORY_SCOPE_AGENT) < 64u && ++sp < (1u << 24)) __builtin_amdgcn_s_sleep(1);
                __builtin_amdgcn_fence(__ATOMIC_ACQUIRE, "agent"); asm volatile("s_waitcnt vmcnt(0)" ::: "memory"); }
            __syncthreads();
            phase_norm(p, l + 1, fin, w, nw, NP, MR);
        } } break;
    }
}

__global__ void __launch_bounds__(512, 2) mega(Params p) {
    extern __shared__ __attribute__((aligned(16))) unsigned char smem[];
    LAS unsigned char* lds = (LAS unsigned char*)smem;
    volatile LAS unsigned* st = (volatile LAS unsigned*)(lds + LDS_PHASE);
    unsigned* bar = (unsigned*)(p.ws + WS_BAR);
    if (p.ph_hi - p.ph_lo > 1) {
        if (threadIdx.x == 0) { st[0] = 0u; st[1] = 0u; (void)xb_add(&bar[XB_XCNT(xb_xcc_id())], 1u); }
        __syncthreads();
    }
    if (p.ph_lo < 0) cg::this_grid().sync();
    for (int ph = p.ph_lo; ph < p.ph_hi; ++ph) {
        if (gridDim.x == 256 && p.ph_hi - p.ph_lo > 1 && (ph == N_PHASES - 1 || (ph >= 9 && (ph - 2) % 7 == 0) || (ph >= 2 && (ph - 2) % 7 == 5))) continue;
        if (ph > p.ph_lo) {
            xcd_barrier(bar, st);
#ifdef EXTRA_SYNC
            xcd_barrier(bar, st);
#endif
        }
        KP* pp = (KP*)__builtin_amdgcn_kernarg_segment_ptr();
        asm volatile("" : "+s"(pp));
        run_phase(*pp, ph, lds);
    }
}

extern "C" void kernel_launch(void* const* d_in, const int* in_sizes, int n_in, void* d_out, int out_size, void* d_ws, size_t ws_size, hipStream_t stream) {
    static int grid = 0;
    if (grid == 0) {
        if (n_in != N_IN || (size_t)out_size != O_END || ws_size < WS_END) { fprintf(stderr, "kernel_launch: unexpected shapes n_in %d out %d ws %zu (need %zu)\n", n_in, out_size, ws_size, (size_t)WS_END); grid = -1; return; }
        int dev = 0, cus = 0, per_cu = 0;
        hipGetDevice(&dev); hipDeviceGetAttribute(&cus, hipDeviceAttributeMultiprocessorCount, dev);
        if (hipFuncSetAttribute((const void*)mega, hipFuncAttributeMaxDynamicSharedMemorySize, LDS_BYTES) != hipSuccess) { fprintf(stderr, "kernel_launch: hipFuncSetAttribute failed\n"); grid = -1; return; }
        hipOccupancyMaxActiveBlocksPerMultiprocessor(&per_cu, (const void*)mega, 512, LDS_BYTES);
        (void)hipGetLastError();
        if (per_cu < 1) { fprintf(stderr, "kernel_launch: occupancy query says %d blocks/CU\n", per_cu); per_cu = 1; }
        grid = cus;
        if (grid % 16) grid -= grid % 16;
    }
    if (grid < 0) return;
    if (hipMemsetAsync((char*)d_ws + WS_BAR, 0, 32768, stream) != hipSuccess) { fprintf(stderr, "kernel_launch: memset failed\n"); return; }
    Params p{};
    for (int i = 0; i < N_IN; ++i) p.in[i] = (const float*)d_in[i];
    p.out = (float*)d_out; p.ws = (unsigned char*)d_ws;
#if MK_MULTI
    for (int ph = 0; ph < N_PHASES; ++ph) { p.ph_lo = ph; p.ph_hi = ph + 1; hipLaunchKernelGGL(mega, dim3(grid), dim3(512), LDS_BYTES, stream, p); }
#else
    p.ph_lo = 0; p.ph_hi = N_PHASES;
    void* args[] = {&p};
    hipError_t e = hipLaunchCooperativeKernel((const void*)mega, dim3(grid), dim3(512), args, LDS_BYTES, stream);
    if (e != hipSuccess) fprintf(stderr, "kernel_launch: cooperative launch failed: %s (grid %d)\n", hipGetErrorString(e), grid);
#endif
}
```
